# Optimizing an MI355X kernel written in HIP

```python
import jax, jax.numpy as jnp
from jax import lax
import numpy as np

D_MODEL = 4096
BATCH = 2
SEQ = 8192
DEPTH = 1
DEC_BATCH = 32
DEC_SEQ = 64
PAST_LEN = 4096

CHUNK = 64
GLA_BLOCK = CHUNK // 4
GLA_HEADS = 4
GLA_K = D_MODEL // 4
GLA_V = D_MODEL // 2
GLA_DK = GLA_K // GLA_HEADS
GLA_DV = GLA_V // GLA_HEADS
GATE_RANK = 16
GATE_NORM = 16.0
CONV_W = D_MODEL // 4
CONV_K = 3
XA_HEADS = 4
XA_W = D_MODEL // 4
XA_DH = XA_W // XA_HEADS
N_MEM = 256
D_FF = ((8 * D_MODEL + 3 * 256 - 1) // (3 * 256)) * 256
N_BRANCH = 3
IN_COLS = 2 * GLA_K + 2 * GLA_V + GATE_RANK + 3 * CONV_W + XA_W + N_BRANCH * D_MODEL
EPS = 1e-6

kernel_name = "hybrid_gla_shortconv_memxattn_stream_step"


def _rmsnorm(x, g):
    xf = x.astype(jnp.float32)
    y = xf * lax.rsqrt(jnp.mean(xf * xf, axis=-1, keepdims=True) + EPS)
    return (y * g.astype(jnp.float32)).astype(x.dtype)


def _gla(q, k, v, log_a, s0):
    B, T, H, _ = q.shape
    DV = v.shape[-1]
    pad = (-T) % GLA_BLOCK
    nb = (T + pad) // GLA_BLOCK

    def blk(a):
        a = jnp.pad(a.astype(jnp.float32), ((0, 0), (0, pad), (0, 0), (0, 0)))
        return jnp.moveaxis(a.reshape(B, nb, GLA_BLOCK, H, a.shape[-1]), 1, 0)

    qb, kb, vb, gb = blk(q), blk(k), blk(v), blk(log_a)
    b = jnp.cumsum(gb, axis=2)
    b_last = b[:, :, -1]
    q_in = qb * jnp.exp(b)
    k_in = kb * jnp.exp(-b)
    k_out = kb * jnp.exp(b_last[:, :, None] - b)
    mask = jnp.tril(jnp.ones((GLA_BLOCK, GLA_BLOCK), dtype=bool))
    scores = jnp.where(mask, jnp.einsum('nbthk,nbshk->nbhts', q_in, k_in), 0.0)
    o_intra = jnp.einsum('nbhts,nbshv->nbthv', scores, vb)

    def step(S, inp):
        qi, ko, vv, bl = inp
        o = jnp.einsum('bthk,bhkv->bthv', qi, S)
        S = jnp.exp(bl)[..., None] * S + jnp.einsum('bshk,bshv->bhkv', ko, vv)
        return S, o

    S, o_inter = lax.scan(step, s0.astype(jnp.float32), (q_in, k_out, vb, b_last))
    o = jnp.moveaxis(o_intra + o_inter, 0, 1).reshape(B, T + pad, H, DV)[:, :T]
    return o.astype(v.dtype), S


def _mem_kv(mem, g_mem, w_mem_kv):
    B, M, _ = mem.shape
    k, v = jnp.split(_rmsnorm(mem, g_mem) @ w_mem_kv, 2, axis=-1)
    return k.reshape(B, M, XA_HEADS, XA_DH), v.reshape(B, M, XA_HEADS, XA_DH)


def _layer(x, s0, buf, mem_k, mem_v, g_mix, w_in, w_a2, b_a, g_gla_out, w_gla_o, w_conv, w_conv_o,
           w_xa_o, b_merge, w_out, g_ffn, w_ffn_gate, w_ffn_up, w_ffn_down):
    B, T, _ = x.shape
    xn = _rmsnorm(x, g_mix)
    z = xn @ w_in
    sizes = (GLA_K, GLA_K, GLA_V, GATE_RANK, GLA_V, CONV_W, CONV_W, CONV_W, XA_W, D_MODEL, D_MODEL, D_MODEL)
    q, k, v, a_lr, r, cb, cc, ch, xq, m0, m1, m2 = jnp.split(z, list(np.cumsum(sizes)[:-1]), axis=-1)

    q = q.reshape(B, T, GLA_HEADS, GLA_DK) * (GLA_DK ** -0.5)
    k = k.reshape(B, T, GLA_HEADS, GLA_DK)
    v = v.reshape(B, T, GLA_HEADS, GLA_DV)
    log_a = (jax.nn.log_sigmoid((a_lr @ w_a2 + b_a).astype(jnp.float32)) / GATE_NORM).reshape(B, T, GLA_HEADS, GLA_DK)
    o, s_new = _gla(q, k, v, log_a, s0)
    o = _rmsnorm(o, g_gla_out).reshape(B, T, GLA_V) * jax.nn.silu(r)
    y_gla = o @ w_gla_o

    u = cc * ch
    full = jnp.concatenate([buf.astype(u.dtype), u], axis=1)
    conv = sum(full[:, j:j + T] * w_conv[j] for j in range(CONV_K))
    new_buf = full[:, -(CONV_K - 1):]
    y_conv = (cb * conv) @ w_conv_o

    xq = xq.reshape(B, T, XA_HEADS, XA_DH)
    s = jnp.einsum('bthd,bmhd->bhtm', xq, mem_k).astype(jnp.float32) * (XA_DH ** -0.5)
    p = jax.nn.softmax(s, axis=-1).astype(x.dtype)
    y_xa = jnp.einsum('bhtm,bmhd->bthd', p, mem_v).reshape(B, T, XA_W) @ w_xa_o

    mixed = (jax.nn.sigmoid(m0 + b_merge[0]) * y_gla + jax.nn.sigmoid(m1 + b_merge[1]) * y_conv
             + jax.nn.sigmoid(m2 + b_merge[2]) * y_xa)
    x = x + mixed @ w_out

    hn = _rmsnorm(x, g_ffn)
    x = x + (jax.nn.silu(hn @ w_ffn_gate) * (hn @ w_ffn_up)) @ w_ffn_down
    return x, s_new.astype(s0.dtype), new_buf.astype(buf.dtype)


def setup_inputs(seed: int = 0) -> dict:
    key = jax.random.key(seed)
    ks = jax.random.split(key, 32)
    f32 = jnp.float32
    nrm = lambda k, shape, s: jax.random.normal(k, shape, f32) * s
    gain = lambda k, shape: 1.0 + 0.02 * jax.random.normal(k, shape, f32)
    L = DEPTH
    return {
        "x_prompt": nrm(ks[0], (BATCH, SEQ, D_MODEL), 1.0),
        "x_sample": nrm(ks[1], (DEC_BATCH, DEC_SEQ, D_MODEL), 1.0),
        "state_gla": nrm(ks[2], (L, DEC_BATCH, GLA_HEADS, GLA_DK, GLA_DV), 1.0),
        "cache_conv": nrm(ks[3], (L, DEC_BATCH, CONV_K - 1, CONV_W), 1.0),
        "cache_mem_k": nrm(ks[4], (L, DEC_BATCH, N_MEM, XA_HEADS, XA_DH), 1.0),
        "cache_mem_v": nrm(ks[5], (L, DEC_BATCH, N_MEM, XA_HEADS, XA_DH), 1.0),
        "mem_prompt": nrm(ks[6], (BATCH, N_MEM, D_MODEL), 1.0),
        "g_mix": gain(ks[7], (L, D_MODEL)),
        "w_in": nrm(ks[8], (L, D_MODEL, IN_COLS), D_MODEL ** -0.5),
        "w_a2": nrm(ks[9], (L, GATE_RANK, GLA_K), GATE_RANK ** -0.5),
        "b_a": nrm(ks[10], (L, GLA_K), 0.1),
        "g_gla_out": gain(ks[11], (L, GLA_DV)),
        "w_gla_o": nrm(ks[12], (L, GLA_V, D_MODEL), GLA_V ** -0.5),
        "w_conv": nrm(ks[13], (L, CONV_K, CONV_W), CONV_K ** -0.5),
        "w_conv_o": nrm(ks[14], (L, CONV_W, D_MODEL), CONV_W ** -0.5),
        "w_xa_o": nrm(ks[15], (L, XA_W, D_MODEL), XA_W ** -0.5),
        "g_mem": gain(ks[16], (L, D_MODEL)),
        "w_mem_kv": nrm(ks[17], (L, D_MODEL, 2 * XA_W), D_MODEL ** -0.5),
        "b_merge": nrm(ks[18], (L, N_BRANCH, D_MODEL), 0.1),
        "w_out": nrm(ks[19], (L, D_MODEL, D_MODEL), D_MODEL ** -0.5),
        "g_ffn": gain(ks[20], (L, D_MODEL)),
        "w_ffn_gate": nrm(ks[21], (L, D_MODEL, D_FF), D_MODEL ** -0.5),
        "w_ffn_up": nrm(ks[22], (L, D_MODEL, D_FF), D_MODEL ** -0.5),
        "w_ffn_down": nrm(ks[23], (L, D_FF, D_MODEL), D_FF ** -0.5),
        "g_final": gain(ks[24], (D_MODEL,)),
    }


def reference(x_prompt, x_sample, state_gla, cache_conv, cache_mem_k, cache_mem_v, mem_prompt,
              g_mix, w_in, w_a2, b_a, g_gla_out, w_gla_o, w_conv, w_conv_o, w_xa_o, g_mem, w_mem_kv,
              b_merge, w_out, g_ffn, w_ffn_gate, w_ffn_up, w_ffn_down, g_final):
    bp = x_prompt.shape[0]
    hp, hs = x_prompt, x_sample
    gla_p, conv_p, mk_p, mv_p, gla_s, conv_s = [], [], [], [], [], []
    for l in range(DEPTH):
        lw = (g_mix[l], w_in[l], w_a2[l], b_a[l], g_gla_out[l], w_gla_o[l], w_conv[l], w_conv_o[l],
              w_xa_o[l], b_merge[l], w_out[l], g_ffn[l], w_ffn_gate[l], w_ffn_up[l], w_ffn_down[l])
        mk, mv = _mem_kv(mem_prompt, g_mem[l], w_mem_kv[l])
        s0 = jnp.zeros((bp, GLA_HEADS, GLA_DK, GLA_DV), state_gla.dtype)
        buf0 = jnp.zeros((bp, CONV_K - 1, CONV_W), cache_conv.dtype)
        hp, sp, bufp = _layer(hp, s0, buf0, mk, mv, *lw)
        hs, ss, bufs = _layer(hs, state_gla[l], cache_conv[l], cache_mem_k[l], cache_mem_v[l], *lw)
        gla_p.append(sp); conv_p.append(bufp); mk_p.append(mk); mv_p.append(mv)
        gla_s.append(ss); conv_s.append(bufs)
    y_prompt = _rmsnorm(hp, g_final)
    y_sample = _rmsnorm(hs, g_final)
    return (y_prompt, y_sample, jnp.stack(gla_p), jnp.stack(conv_p), jnp.stack(mk_p), jnp.stack(mv_p),
            jnp.stack(gla_s), jnp.stack(conv_s))
```

```cpp
#include <hip/hip_runtime.h>
#include <cstdio>
#include <cstdint>

namespace pg8 {
#define PG8_LAS __attribute__((address_space(3)))
typedef unsigned short bf16_t;
typedef short bf16x8 __attribute__((ext_vector_type(8)));
typedef float f32x4 __attribute__((ext_vector_type(4)));
typedef unsigned u32x4 __attribute__((ext_vector_type(4)));
constexpr int BM = 256, BK = 64, HALF = 128, HTB = HALF * BK * 2  , STAGE_BYTES = 8 * HTB, NXCD = 8, WGM = 8;

__host__ __device__ __forceinline__ int lds_byte(int r, int c) { const int st = (r >> 4) * 2 + (c >> 5), rr = r & 15, cc = c & 31, ob = rr * 64 + cc * 2; return st * 1024 + (ob ^ (((ob >> 9) & 1) << 5)); }
__host__ __device__ __forceinline__ void stage_rc(int b, int& R, int& C) { const int st = b / 1024, sb = b % 1024, swz = sb ^ (((sb >> 9) & 1) << 5); R = (st >> 1) * 16 + swz / 64; C = (st & 1) * 32 + (swz % 64) / 2; }
__host__ __device__ __forceinline__ int perm32(int rho) { const int n = rho >> 4, i = rho & 15; return 8 * (i >> 2) + 4 * n + (i & 3); }

struct Unit { int pm, pn; };
struct Gemm { const bf16_t* A; const bf16_t* Bt; int M, N, K; };

struct StaticOrder {
    int nM, nN, nwg, G, c;
    __host__ __device__ void init(int M, int N, int G_, int c_) { nM = M / BM; nN = N / BM; nwg = nM * nN; G = G_; c = c_; }
    __host__ __device__ bool next(int i, Unit& u) const {
        const long L = (long)i * G + c; if (L >= nwg || c < 0) return false;
        int wgid = (int)L; { const int q = nwg / NXCD, r = nwg % NXCD, xcd = wgid % NXCD, off = wgid / NXCD; wgid = (xcd < r ? xcd * (q + 1) : r * (q + 1) + (xcd - r) * q) + off; }
        const int nig = WGM * nN, gid = wgid / nig, fm = gid * WGM, gsz = (nM - fm) < WGM ? (nM - fm) : WGM;
        u.pm = fm + ((wgid % nig) % gsz); u.pn = (wgid % nig) / gsz; return true;
    }
    __device__ __forceinline__ void a_ready(const Unit&) const {}
    __device__ __forceinline__ void done(const Unit&) const {}
};

typedef __bf16 bf16x2_t __attribute__((ext_vector_type(2)));
typedef float f32x2_t __attribute__((ext_vector_type(2)));
__device__ __forceinline__ unsigned cvt_pk_bf16(float lo, float hi) { const f32x2_t f = {lo, hi}; const bf16x2_t b = __builtin_convertvector(f, bf16x2_t); return __builtin_bit_cast(unsigned, b); }

template <class Epi, class Sched, bool ALIGN_EPI = false, bool SP2 = false>
__device__ __forceinline__ void gemm_phase(PG8_LAS unsigned char* lds, const Gemm g, const Sched& S, const Epi& E) {
    int tid_ = threadIdx.x; asm volatile("" : "+v"(tid_)); const int tid = tid_, wid = __builtin_amdgcn_readfirstlane(tid >> 6), lane = tid & 63, wr = wid >> 2, wc = wid & 3, fr = lane & 15, fq = lane >> 4;
    const int K = g.K, nt = K / BK;
    unsigned voffA[2], voffB[2];
#pragma unroll
    for (int i = 0; i < 2; ++i) { int R, C; stage_rc(tid * 16 + i * 8192, R, C); const int Rb = Epi::PERM ? ((R & ~31) + perm32(R & 31)) : R;
        voffA[i] = (unsigned)(R * K + C) * 2u; voffB[i] = (unsigned)(Rb * K + C) * 2u; }
    const size_t kstep = (size_t)(BK * 2);
    const size_t hstep = (size_t)HALF * K * 2;
    const size_t tstep = 2 * hstep;
    const unsigned ldsw = (unsigned)wid * 1024u;
    const int aoff = lds_byte(wr * 64 + fr, fq * 8), boff = lds_byte(wc * 32 + fr, fq * 8);
#define PG8_SA(b, h) (((b) * 2 + (h)) * HTB)
#define PG8_SB(b, h) ((4 + (b) * 2 + (h)) * HTB)
#define PG8_STAGE(bufoff, gbase, voff) do { _Pragma("unroll") for (int _i = 0; _i < 2; ++_i) \
        __builtin_amdgcn_global_load_lds((const unsigned*)((const char*)(gbase) + (voff)[_i]), (PG8_LAS unsigned*)(lds + (bufoff) + ldsw + _i * 8192), 16, 0, 0); } while (0)
#define PG8_LDA(dst, b, h) do { _Pragma("unroll") for (int m = 0; m < 4; ++m) _Pragma("unroll") for (int k = 0; k < 2; ++k) dst[m][k] = *(const PG8_LAS bf16x8*)(lds + PG8_SA(b, h) + aoff + m * 2048 + k * 1024); } while (0)
#define PG8_LDB(dst, b, h) do { _Pragma("unroll") for (int n = 0; n < 2; ++n) _Pragma("unroll") for (int k = 0; k < 2; ++k) dst[n][k] = *(const PG8_LAS bf16x8*)(lds + PG8_SB(b, h) + boff + n * 2048 + k * 1024); } while (0)
#define PG8_MMA(ai, bj, At, Bt) do { __builtin_amdgcn_s_setprio(1); _Pragma("unroll") for (int m = 0; m < 4; ++m) _Pragma("unroll") for (int n = 0; n < 2; ++n) _Pragma("unroll") for (int k = 0; k < 2; ++k) \
        acc[ai][bj][m][n] = __builtin_amdgcn_mfma_f32_16x16x32_bf16(Bt[n][k], At[m][k], acc[ai][bj][m][n], 0, 0, 0); __builtin_amdgcn_s_setprio(0); } while (0)
#define PG8_WAIT_V(n) asm volatile("s_waitcnt vmcnt(" #n ")" ::: "memory")
#define PG8_WAIT_L(n) asm volatile("s_waitcnt lgkmcnt(" #n ")" ::: "memory")
#define PG8_BAR __builtin_amdgcn_s_barrier()
#define PG8_SCHED __builtin_amdgcn_sched_barrier(0)
    Unit cur, nxt; int ui = 0;
    if (!S.next(0, cur)) return;
    f32x4 acc[2][2][4][2];
#pragma unroll
    for (int a = 0; a < 2; ++a)
#pragma unroll
        for (int b = 0; b < 2; ++b)
#pragma unroll
            for (int m = 0; m < 4; ++m)
#pragma unroll
                for (int n = 0; n < 2; ++n) acc[a][b][m][n] = (f32x4){0.f, 0.f, 0.f, 0.f};
    bf16x8 At[4][2], B0[2][2], B1[2][2];
    const char* cA = (const char*)g.A + (size_t)cur.pm * tstep; const char* cB = (const char*)g.Bt + (size_t)cur.pn * tstep;
    S.a_ready(cur);
    if constexpr (SP2) {
        PG8_STAGE(PG8_SB(0, 0), cB, voffB); PG8_STAGE(PG8_SB(0, 1), cB + hstep, voffB); PG8_STAGE(PG8_SA(0, 0), cA, voffA); PG8_STAGE(PG8_SA(0, 1), cA + hstep, voffA);
        if (wr == 1) PG8_BAR;
        PG8_WAIT_V(2); PG8_BAR;
        PG8_STAGE(PG8_SB(1, 0), cB + kstep, voffB); PG8_STAGE(PG8_SA(1, 0), cA + kstep, voffA); PG8_STAGE(PG8_SB(1, 1), cB + hstep + kstep, voffB);
        PG8_WAIT_V(6); PG8_BAR;
    } else {
        PG8_STAGE(PG8_SB(0, 0), cB, voffB); PG8_STAGE(PG8_SA(0, 0), cA, voffA); PG8_STAGE(PG8_SB(0, 1), cB + hstep, voffB); PG8_STAGE(PG8_SA(0, 1), cA + hstep, voffA);
        if (wr == 1) PG8_BAR;
        PG8_WAIT_V(4); PG8_BAR;
        PG8_STAGE(PG8_SB(1, 0), cB + kstep, voffB); PG8_STAGE(PG8_SA(1, 0), cA + kstep, voffA); PG8_STAGE(PG8_SB(1, 1), cB + hstep + kstep, voffB);
        PG8_WAIT_V(6); PG8_BAR;
    }
    for (;;) {
        const bool has_next = S.next(ui + 1, nxt);
        const char* nA = has_next ? (const char*)g.A + (size_t)nxt.pm * tstep : cA; const char* nB = has_next ? (const char*)g.Bt + (size_t)nxt.pn * tstep : cB;
        for (int t = 0; t < nt; t += 2) {
            const bool last = (t == nt - 2);
            const char* a1 = cA + (size_t)(t + 1) * kstep;
            const char* a2 = last ? nA : cA + (size_t)(t + 2) * kstep; const char* b2 = last ? nB : cB + (size_t)(t + 2) * kstep;
            const char* a3 = a2 + kstep; const char* b3 = b2 + kstep;
            if (last && has_next) S.a_ready(nxt);
            if constexpr (Epi::KHOOK) { if (t == 32 || t == 48) E.khook(acc, cur, t == 32 ? 0 : 1, wr, wc, fr, fq); }
            if constexpr (SP2) {
            PG8_LDB(B0, 0, 0); PG8_LDB(B1, 0, 1); PG8_SCHED; PG8_LDA(At, 0, 0); PG8_STAGE(PG8_SA(1, 1), a1 + hstep, voffA);
            PG8_WAIT_V(8); PG8_WAIT_L(0); PG8_BAR; PG8_MMA(0, 0, At, B0); PG8_MMA(0, 1, At, B1); PG8_BAR; PG8_SCHED;
            PG8_LDA(At, 0, 1); PG8_STAGE(PG8_SB(0, 0), b2, voffB); PG8_STAGE(PG8_SB(0, 1), b2 + hstep, voffB); PG8_STAGE(PG8_SA(0, 0), a2, voffA);
            PG8_WAIT_V(8); PG8_WAIT_L(0); PG8_BAR; PG8_MMA(1, 0, At, B0); PG8_MMA(1, 1, At, B1); PG8_BAR; PG8_SCHED;
            PG8_LDB(B0, 1, 0); PG8_LDB(B1, 1, 1); PG8_SCHED; PG8_LDA(At, 1, 0); PG8_STAGE(PG8_SA(0, 1), a2 + hstep, voffA);
            PG8_WAIT_V(8); PG8_WAIT_L(0); PG8_BAR; PG8_MMA(0, 0, At, B0); PG8_MMA(0, 1, At, B1); PG8_BAR; PG8_SCHED;
            PG8_LDA(At, 1, 1); PG8_STAGE(PG8_SB(1, 0), b3, voffB); PG8_STAGE(PG8_SB(1, 1), b3 + hstep, voffB); PG8_STAGE(PG8_SA(1, 0), a3, voffA);
            PG8_WAIT_V(8); PG8_WAIT_L(0); PG8_BAR; PG8_MMA(1, 0, At, B0); PG8_MMA(1, 1, At, B1); PG8_BAR; PG8_SCHED;
            } else {
            PG8_LDB(B0, 0, 0); PG8_SCHED; PG8_LDA(At, 0, 0); PG8_STAGE(PG8_SA(1, 1), a1 + hstep, voffA);
            PG8_WAIT_L(8); PG8_BAR; PG8_WAIT_L(0); PG8_MMA(0, 0, At, B0); PG8_BAR; PG8_SCHED;
            PG8_LDB(B1, 0, 1); PG8_STAGE(PG8_SB(0, 0), b2, voffB);
            PG8_BAR; PG8_WAIT_L(0); PG8_MMA(0, 1, At, B1); PG8_BAR;
            PG8_LDA(At, 0, 1); PG8_STAGE(PG8_SA(0, 0), a2, voffA);
            PG8_BAR; PG8_WAIT_L(0); PG8_MMA(1, 0, At, B0); PG8_BAR; PG8_SCHED;
            PG8_STAGE(PG8_SB(0, 1), b2 + hstep, voffB);
            PG8_WAIT_V(6); PG8_BAR; PG8_MMA(1, 1, At, B1); PG8_BAR;
            PG8_LDB(B0, 1, 0); PG8_SCHED; PG8_LDA(At, 1, 0); PG8_STAGE(PG8_SA(0, 1), a2 + hstep, voffA);
            PG8_WAIT_L(8); PG8_BAR; PG8_WAIT_L(0); PG8_MMA(0, 0, At, B0); PG8_BAR; PG8_SCHED;
            PG8_LDB(B1, 1, 1); PG8_STAGE(PG8_SB(1, 0), b3, voffB);
            PG8_BAR; PG8_WAIT_L(0); PG8_MMA(0, 1, At, B1); PG8_BAR;
            PG8_LDA(At, 1, 1); PG8_STAGE(PG8_SA(1, 0), a3, voffA);
            PG8_BAR; PG8_WAIT_L(0); PG8_MMA(1, 0, At, B0); PG8_BAR; PG8_SCHED;
            PG8_STAGE(PG8_SB(1, 1), b3 + hstep, voffB);
            PG8_WAIT_V(6); PG8_BAR; PG8_MMA(1, 1, At, B1); PG8_BAR;
            }
        }
        if constexpr (ALIGN_EPI) { if (wr == 0) PG8_BAR; }
        E(acc, cur, wr, wc, fr, fq); S.done(cur);
        if (!has_next) break;
#pragma unroll
        for (int a = 0; a < 2; ++a)
#pragma unroll
            for (int b = 0; b < 2; ++b)
#pragma unroll
                for (int m = 0; m < 4; ++m)
#pragma unroll
                    for (int n = 0; n < 2; ++n) acc[a][b][m][n] = (f32x4){0.f, 0.f, 0.f, 0.f};
        cur = nxt; cA = nA; cB = nB; ++ui;
        if constexpr (ALIGN_EPI) { if (wr == 1) PG8_BAR; }
    }
    PG8_WAIT_V(0);
    if constexpr (!ALIGN_EPI) { if (wr == 0) PG8_BAR; }
    PG8_BAR;
#undef PG8_SA
#undef PG8_SB
#undef PG8_STAGE
#undef PG8_LDA
#undef PG8_LDB
#undef PG8_MMA
#undef PG8_WAIT_V
#undef PG8_WAIT_L
#undef PG8_BAR
#undef PG8_SCHED
}
}

constexpr int NWAVES = 8, NTHR = NWAVES * 64;
constexpr int DM = 4096, TP = 2 * 8192, TS = 32 * 64, T = TP + TS;
constexpr int SEQP = 8192, NCHK = T / 64, NCHK_P = TP / 64;
constexpr int GK = 1024, GV = 2048, DK = 256, DV = 512, NH = 4, RANK = 16;
constexpr int CW = 1024, XW = 1024, XDH = 256, NMEM = 256, DFF = 11008;
constexpr int IN_COLS = 22544;
constexpr int ZS_LD = 10240, G_LD = 12288;
constexpr int ZQ = 0, ZK = 1024, ZV = 2048, ZR = 4096, ZCB = 6144, ZCC = 7168, ZCH = 8192, ZXQ = 9216;
constexpr int NIN_T = 22784;
constexpr int NGU_T = 22016;
constexpr float EPS = 1e-6f;
constexpr size_t O_Y = 0, O_SGP = 75497472, O_CCP = 76546048, O_MKP = 76550144, O_MVP = 77074432, O_SGS = 77598720, O_CCS = 94375936;
constexpr size_t MiB = 1u << 20;
constexpr size_t WS_CTL = 0, CTL_ZERO_BYTES = 1 * MiB;
constexpr size_t WS_RA = 1 * MiB;
constexpr size_t WS_DS0 = WS_RA, WS_DSS = WS_RA + 128 * MiB;
constexpr size_t WS_WBR = 180 * MiB, WS_WOUT = 212 * MiB, WS_WKV = 244 * MiB;
constexpr size_t WS_ZS = 260 * MiB;
constexpr size_t WS_MIX = WS_ZS, WS_HN = WS_ZS + 144 * MiB;
constexpr size_t WS_GATES = 620 * MiB;
constexpr size_t WS_DS1 = 1052 * MiB;
constexpr size_t WS_MKV = 1180 * MiB;
constexpr size_t WS_ALR = 1214 * MiB, WS_MEMN = 1216 * MiB, WS_AOUT = 1220 * MiB, WS_WDN = 1222 * MiB, WS_END = 1308 * MiB;
constexpr size_t OY_XN = 0, OY_BR = (size_t)T * DM * 2;

constexpr int CW_BAR = 4096;
constexpr int RING_BYTES = 131072, LDSCTL_OFF = RING_BYTES, MISC_OFF = LDSCTL_OFF + 320, LDS_BYTES = 147456;

#define GAS __attribute__((address_space(1)))
#define LAS __attribute__((address_space(3)))
typedef unsigned short bf16;
typedef unsigned v4u __attribute__((ext_vector_type(4)));
typedef unsigned v2u __attribute__((ext_vector_type(2)));
typedef float f32x4 __attribute__((ext_vector_type(4)));
#define LDS_WAIT() asm volatile("s_waitcnt lgkmcnt(0)" ::: "memory")
#define VM_WAIT() asm volatile("s_waitcnt vmcnt(0)" ::: "memory")
__device__ __forceinline__ float bf_lo(unsigned w) { return __uint_as_float(w << 16); }
__device__ __forceinline__ float bf_hi(unsigned w) { return __uint_as_float(w & 0xffff0000u); }
__device__ __forceinline__ float bf1(bf16 b) { return __uint_as_float(((unsigned)b) << 16); }
__device__ __forceinline__ unsigned pk2(float lo, float hi) { return pg8::cvt_pk_bf16(lo, hi); }
__device__ __forceinline__ bf16 f2bf1(float f) { return (bf16)(pg8::cvt_pk_bf16(f, 0.f) & 0xffffu); }
__device__ __forceinline__ void unpack8(const v4u w, float (&f)[8]) { f[0] = bf_lo(w.x); f[1] = bf_hi(w.x); f[2] = bf_lo(w.y); f[3] = bf_hi(w.y); f[4] = bf_lo(w.z); f[5] = bf_hi(w.z); f[6] = bf_lo(w.w); f[7] = bf_hi(w.w); }
__device__ __forceinline__ v4u pack8(const float (&f)[8]) { v4u w; w.x = pk2(f[0], f[1]); w.y = pk2(f[2], f[3]); w.z = pk2(f[4], f[5]); w.w = pk2(f[6], f[7]); return w; }
__device__ __forceinline__ float sigmoidf_(float x) { return __builtin_amdgcn_rcpf(1.f + __expf(-x)); }
__device__ __forceinline__ float wave_sum(float v) {
#pragma unroll
    for (int o = 1; o < 64; o <<= 1) v += __shfl_xor(v, o);
    return v;
}
__device__ __forceinline__ float wave_max(float v) {
#pragma unroll
    for (int o = 1; o < 64; o <<= 1) v = fmaxf(v, __shfl_xor(v, o));
    return v;
}

#define XB_TMO      128
#define XB_XCNT(j)  (256  + 64 * (j))
#define XB_XSUB(j)  (1280 + 64 * (j))
#define XB_XGEN(j)  (2304 + 64 * (j))
#define XB_TOP      3328
#define XB_TOPGEN   3392
#define XCD_BAR_WORDS 3456
#define XB_SPIN_CAP (1u << 22)
__device__ __forceinline__ unsigned xb_ld(unsigned* p)              { return __hip_atomic_load(p, __ATOMIC_RELAXED, __HIP_MEMORY_SCOPE_AGENT); }
__device__ __forceinline__ unsigned xb_add(unsigned* p, unsigned v) { return __hip_atomic_fetch_add(p, v, __ATOMIC_RELAXED, __HIP_MEMORY_SCOPE_AGENT); }
__device__ __forceinline__ unsigned xb_xcc_id() { return (unsigned)__builtin_amdgcn_s_getreg((3 << 11) | 20) & 0xFu; }
#define XB_SPIN(cond, bar) do { unsigned _sp = 0; while (cond) { __builtin_amdgcn_s_sleep(1); \
    if ((++_sp & 255u) == 0u) { if (xb_ld(&(bar)[XB_TMO])) break; if (_sp > XB_SPIN_CAP) { atomicAdd(&(bar)[XB_TMO], 1u); break; } } } } while (0)
struct XcdBarrier { unsigned* bar; unsigned x; volatile LAS unsigned* st; };
__device__ __forceinline__ XcdBarrier xcd_barrier_post(unsigned* bar, volatile LAS unsigned* st) {
    XcdBarrier b; b.bar = bar; b.x = xb_xcc_id(); b.st = st;
    if (threadIdx.x == 0) (void)xb_add(&bar[XB_XCNT(b.x)], 1u);
    return b;
}
__device__ __forceinline__ void xcd_barrier_complete(unsigned* bar, unsigned x, unsigned& nloc, unsigned& nx) {
    const unsigned G = gridDim.x * gridDim.y * gridDim.z;
    unsigned sum, cnt, mine, sp = 0u;
    for (;;) {
        sum = 0u; cnt = 0u; mine = 0u;
#pragma unroll
        for (unsigned j = 0; j < 16; ++j) { const unsigned c = xb_ld(&bar[XB_XCNT(j)]); sum += c; cnt += (c > 0u) ? 1u : 0u; mine = (j == x) ? c : mine; }
        if (sum == G) break;
        __builtin_amdgcn_s_sleep(1);
        if ((++sp & 255u) == 0u) { if (xb_ld(&bar[XB_TMO])) break; if (sp > XB_SPIN_CAP) { atomicAdd(&bar[XB_TMO], 1u); break; } }
    }
    nloc = mine > 0u ? mine : 1u; nx = cnt > 0u ? cnt : 1u;
}
__device__ __forceinline__ void xcd_barrier(const XcdBarrier& b) {
    asm volatile("s_waitcnt vmcnt(0)" ::: "memory");
    __syncthreads();
    if (threadIdx.x == 0) {
        unsigned* bar = b.bar;
        __builtin_amdgcn_s_waitcnt(0);
        unsigned nloc = b.st[0], nx = b.st[1];
        if (nloc == 0u) { xcd_barrier_complete(bar, b.x, nloc, nx); b.st[0] = nloc; b.st[1] = nx; }
        const unsigned old = xb_add(&bar[XB_XSUB(b.x)], 1u);
        const unsigned gen = old / nloc;
        if (old + 1u == (gen + 1u) * nloc) {
            __builtin_amdgcn_fence(__ATOMIC_RELEASE, "agent");
            asm volatile("s_waitcnt vmcnt(0)" ::: "memory");
            const unsigned og = xb_add(&bar[XB_TOP], 1u);
            const unsigned tg = og / nx;
            if (og + 1u == (tg + 1u) * nx) xb_add(&bar[XB_TOPGEN], 1u);
            else XB_SPIN(xb_ld(&bar[XB_TOPGEN]) == tg, bar);
            __builtin_amdgcn_fence(__ATOMIC_ACQUIRE, "agent");
            xb_add(&bar[XB_XGEN(b.x)], 1u);
            asm volatile("s_waitcnt vmcnt(0)" ::: "memory");
        } else {
            XB_SPIN(xb_ld(&bar[XB_XGEN(b.x)]) == gen, bar);
            __builtin_amdgcn_fence(__ATOMIC_ACQUIRE, "agent");
            asm volatile("s_waitcnt vmcnt(0)" ::: "memory");
        }
    }
    __syncthreads();
}

struct Frame {
    LAS unsigned char* lds;
    int wave, vcu, G;
    const float* in[25];
    float* out; unsigned char* ws;
};
enum InIdx { I_XP = 0, I_XS, I_SGLA, I_CCONV, I_CMK, I_CMV, I_MEMP, I_GMIX, I_WIN, I_WA2, I_BA, I_GGLA, I_WGLAO, I_WCONV, I_WCONVO, I_WXAO, I_GMEM, I_WMEMKV, I_BMERGE, I_WOUT, I_GFFN, I_WFG, I_WFU, I_WFD, I_GFINAL };

__device__ __forceinline__ const float* xrow_ptr(const Frame& F, int row) { return row < TP ? F.in[I_XP] + (size_t)row * DM : F.in[I_XS] + (size_t)(row - TP) * DM; }
__device__ __forceinline__ void chunk_seq(int ci, int& seq, int& cis) { if (ci < NCHK_P) { seq = ci >> 7; cis = ci & 127; } else { seq = 2 + (ci - NCHK_P); cis = 0; } }
__device__ __forceinline__ bf16* slot_ptr(const Frame& F, int ci, int h) {
    if (ci < 128) return (bf16*)(F.ws + WS_DS0) + ((size_t)(ci * NH + h) << 17);
    if (ci < 256) return (bf16*)(F.ws + WS_DS1) + ((size_t)((ci - 128) * NH + h) << 17);
    return (bf16*)(F.ws + WS_DSS) + ((size_t)((ci - 256) * NH + h) << 17);
}

__device__ __forceinline__ void tr_item(const float* Wp, size_t ldw, int nvalid, float scale, bf16* WTp, size_t ldt, LAS float* scr, int lane) {
    const int n = lane & 31;
#pragma unroll 8
    for (int i = 0; i < 32; ++i) { const int kk = 2 * i + (lane >> 5); scr[kk * 33 + n] = (n < nvalid) ? Wp[(size_t)kk * ldw + n] * scale : 0.f; }
    LDS_WAIT(); asm volatile("" ::: "memory");
    const int c = lane & 7;
#pragma unroll
    for (int j = 0; j < 4; ++j) { const int nn = (lane >> 3) + 8 * j; const LAS float* s = scr + (8 * c) * 33 + nn;
        v4u o; o.x = pk2(s[0 * 33], s[1 * 33]); o.y = pk2(s[2 * 33], s[3 * 33]); o.z = pk2(s[4 * 33], s[5 * 33]); o.w = pk2(s[6 * 33], s[7 * 33]);
        *(v4u*)(WTp + (size_t)nn * ldt + 8 * c) = o; }
    LDS_WAIT(); asm volatile("" ::: "memory");
}
__device__ __forceinline__ void rms_row_to_bf16(const float* xrow, const float* g, bf16* orow, int lane) {
    const f32x4* xr = (const f32x4*)xrow + lane; const f32x4* gr = (const f32x4*)g + lane;
    f32x4 v[16]; float s = 0.f;
#pragma unroll
    for (int j = 0; j < 16; ++j) { v[j] = xr[64 * j]; s += (v[j].x * v[j].x + v[j].y * v[j].y) + (v[j].z * v[j].z + v[j].w * v[j].w); }
    const float rstd = rsqrtf(wave_sum(s) * (1.f / DM) + EPS);
    v2u* o8 = (v2u*)orow + lane;
#pragma unroll
    for (int j = 0; j < 16; ++j) { const f32x4 gg = gr[64 * j]; v2u w; w.x = pk2(v[j].x * rstd * gg.x, v[j].y * rstd * gg.y); w.y = pk2(v[j].z * rstd * gg.z, v[j].w * rstd * gg.w); o8[64 * j] = w; }
}

namespace pg8 {
struct EpiZ {
    static constexpr bool PERM = true, KHOOK = false;
    bf16_t* zs; float* alr; bf16_t* gates; const float* bmerge;
    __device__ __forceinline__ void operator()(const f32x4 (&acc)[2][2][4][2], const Unit& u, int wr, int wc, int fr, int fq) const {
        const int row0 = u.pm * BM + wr * 64 + fr;
        if (u.pn < 40) {
            const int col0 = u.pn * BM + wc * 32 + 8 * fq;
#pragma unroll
            for (int ai = 0; ai < 2; ++ai)
#pragma unroll
                for (int m = 0; m < 4; ++m) { bf16_t* rowp = zs + (size_t)(row0 + ai * HALF + m * 16) * ZS_LD + col0;
#pragma unroll
                    for (int bj = 0; bj < 2; ++bj) { const f32x4 v0 = acc[ai][bj][m][0], v1 = acc[ai][bj][m][1];
                        u32x4 w; w.x = cvt_pk_bf16(v0[0], v0[1]); w.y = cvt_pk_bf16(v0[2], v0[3]); w.z = cvt_pk_bf16(v1[0], v1[1]); w.w = cvt_pk_bf16(v1[2], v1[3]);
                        *(u32x4*)(rowp + bj * HALF) = w; } }
        } else if (u.pn == 40) {
            if (wc == 0 && fq < 2) {
#pragma unroll
                for (int ai = 0; ai < 2; ++ai)
#pragma unroll
                    for (int m = 0; m < 4; ++m) { float* rp = alr + (size_t)(row0 + ai * HALF + m * 16) * RANK + 8 * fq;
                        *(f32x4*)rp = acc[ai][0][m][0]; *(f32x4*)(rp + 4) = acc[ai][0][m][1]; }
            }
        } else {
            const int col0 = (u.pn - 41) * BM + wc * 32 + 8 * fq;
            f32x4 bv[2][2];
#pragma unroll
            for (int bj = 0; bj < 2; ++bj)
#pragma unroll
                for (int n = 0; n < 2; ++n) bv[bj][n] = *(const f32x4*)(bmerge + col0 + bj * HALF + 4 * n);
#pragma unroll
            for (int ai = 0; ai < 2; ++ai)
#pragma unroll
                for (int m = 0; m < 4; ++m) { bf16_t* rowp = gates + (size_t)(row0 + ai * HALF + m * 16) * G_LD + col0;
#pragma unroll
                    for (int bj = 0; bj < 2; ++bj) { f32x4 v0 = acc[ai][bj][m][0] + bv[bj][0], v1 = acc[ai][bj][m][1] + bv[bj][1];
#pragma unroll
                        for (int j = 0; j < 4; ++j) { v0[j] = sigmoidf_(v0[j]); v1[j] = sigmoidf_(v1[j]); }
                        u32x4 w; w.x = cvt_pk_bf16(v0[0], v0[1]); w.y = cvt_pk_bf16(v0[2], v0[3]); w.z = cvt_pk_bf16(v1[0], v1[1]); w.w = cvt_pk_bf16(v1[2], v1[3]);
                        *(u32x4*)(rowp + bj * HALF) = w; } }
        }
    }
};
struct EpiKV {
    static constexpr bool PERM = true, KHOOK = false;
    float* outk; float* outv; bf16_t* mkv;
    __device__ __forceinline__ void operator()(const f32x4 (&acc)[2][2][4][2], const Unit& u, int wr, int wc, int fr, int fq) const {
        const int row0 = u.pm * BM + wr * 64 + fr, col0 = u.pn * BM + wc * 32 + 8 * fq;
        float* ob = col0 < 1024 ? outk + col0 : outv + (col0 - 1024);
#pragma unroll
        for (int ai = 0; ai < 2; ++ai)
#pragma unroll
            for (int m = 0; m < 4; ++m) { const int row = row0 + ai * HALF + m * 16;
#pragma unroll
                for (int bj = 0; bj < 2; ++bj) { const f32x4 v0 = acc[ai][bj][m][0], v1 = acc[ai][bj][m][1];
                    float* op = ob + (size_t)row * 1024 + bj * HALF; *(f32x4*)op = v0; *(f32x4*)(op + 4) = v1;
                    u32x4 w; w.x = cvt_pk_bf16(v0[0], v0[1]); w.y = cvt_pk_bf16(v0[2], v0[3]); w.z = cvt_pk_bf16(v1[0], v1[1]); w.w = cvt_pk_bf16(v1[2], v1[3]);
                    *(u32x4*)(mkv + (size_t)row * 2048 + col0 + bj * HALF) = w; } }
    }
};
struct EpiMix {
    static constexpr bool PERM = true, KHOOK = true;
    const bf16_t* gates; bf16_t* mixed;
    __device__ __forceinline__ void khook(f32x4 (&acc)[2][2][4][2], const Unit& u, int seg, int wr, int wc, int fr, int fq) const {
        const unsigned char* gb0 = (const unsigned char*)gates + ((size_t)(u.pm * BM + wr * 64) * G_LD + seg * DM + u.pn * BM + wc * 32) * 2;
        const unsigned lo = (unsigned)(fr * G_LD + 8 * fq) * 2u;
#pragma unroll
        for (int ai = 0; ai < 2; ++ai)
#pragma unroll
            for (int m = 0; m < 4; ++m) {
                u32x4 ga[2], gb[2];
#pragma unroll
                for (int bj = 0; bj < 2; ++bj) { const unsigned char* p = gb0 + (size_t)((ai * HALF + m * 16) * G_LD + bj * HALF) * 2; ga[bj] = *(const u32x4*)(p + lo); gb[bj] = *(const u32x4*)(p + DM * 2 + lo); }
#pragma unroll
                for (int bj = 0; bj < 2; ++bj) { float a[8], b[8]; unpack8(ga[bj], a); unpack8(gb[bj], b);
#pragma unroll
                    for (int j = 0; j < 4; ++j) { acc[ai][bj][m][0][j] *= a[j] * __builtin_amdgcn_rcpf(fmaxf(b[j], 1e-30f)); acc[ai][bj][m][1][j] *= a[4 + j] * __builtin_amdgcn_rcpf(fmaxf(b[4 + j], 1e-30f)); } }
                __builtin_amdgcn_sched_barrier(0);
            }
    }
    __device__ __forceinline__ void operator()(const f32x4 (&acc)[2][2][4][2], const Unit& u, int wr, int wc, int fr, int fq) const {
        const int row0 = u.pm * BM + wr * 64 + fr, col0 = u.pn * BM + wc * 32 + 8 * fq;
#pragma unroll
        for (int ai = 0; ai < 2; ++ai)
#pragma unroll
            for (int m = 0; m < 4; ++m) { const size_t row = (size_t)(row0 + ai * HALF + m * 16);
#pragma unroll
                for (int bj = 0; bj < 2; ++bj) { float g[8]; unpack8(*(const u32x4*)(gates + row * G_LD + 2 * DM + col0 + bj * HALF), g);
                    const f32x4 v0 = acc[ai][bj][m][0], v1 = acc[ai][bj][m][1];
                    u32x4 w; w.x = cvt_pk_bf16(v0[0] * g[0], v0[1] * g[1]); w.y = cvt_pk_bf16(v0[2] * g[2], v0[3] * g[3]); w.z = cvt_pk_bf16(v1[0] * g[4], v1[1] * g[5]); w.w = cvt_pk_bf16(v1[2] * g[6], v1[3] * g[7]);
                    *(u32x4*)(mixed + row * DM + col0 + bj * HALF) = w; } }
    }
};
struct EpiX1 {
    static constexpr bool PERM = false, KHOOK = false;
    const float* xp; const float* xs; float* out;
    __device__ __forceinline__ void operator()(const f32x4 (&acc)[2][2][4][2], const Unit& u, int wr, int wc, int fr, int fq) const {
        const int row0 = u.pm * BM + wr * 64 + fr, col0 = u.pn * BM + wc * 32 + 4 * fq;
#pragma unroll
        for (int ai = 0; ai < 2; ++ai)
#pragma unroll
            for (int m = 0; m < 4; ++m) { const int row = row0 + ai * HALF + m * 16; const float* xr = (row < TP ? xp + (size_t)row * DM : xs + (size_t)(row - TP) * DM) + col0; float* orow = out + (size_t)row * DM + col0;
#pragma unroll
                for (int bj = 0; bj < 2; ++bj)
#pragma unroll
                    for (int n = 0; n < 2; ++n) *(f32x4*)(orow + bj * HALF + n * 16) = *(const f32x4*)(xr + bj * HALF + n * 16) + acc[ai][bj][m][n]; }
    }
};
struct EpiGU {
    static constexpr bool PERM = true, KHOOK = false;
    bf16_t* h;
    __device__ __forceinline__ void operator()(const f32x4 (&acc)[2][2][4][2], const Unit& u, int wr, int wc, int fr, int fq) const {
        const int row0 = u.pm * BM + wr * 64 + fr, col0 = u.pn * HALF + wc * 32 + 8 * fq;
#pragma unroll
        for (int ai = 0; ai < 2; ++ai)
#pragma unroll
            for (int m = 0; m < 4; ++m) { float o[8];
#pragma unroll
                for (int n = 0; n < 2; ++n)
#pragma unroll
                    for (int j = 0; j < 4; ++j) { const float gt = acc[ai][0][m][n][j], up = acc[ai][1][m][n][j]; o[4 * n + j] = gt * sigmoidf_(gt) * up; }
                u32x4 w; w.x = cvt_pk_bf16(o[0], o[1]); w.y = cvt_pk_bf16(o[2], o[3]); w.z = cvt_pk_bf16(o[4], o[5]); w.w = cvt_pk_bf16(o[6], o[7]);
                *(u32x4*)(h + (size_t)(row0 + ai * HALF + m * 16) * DFF + col0) = w; }
    }
};
struct EpiDown {
    static constexpr bool PERM = false, KHOOK = false;
    float* out;
    __device__ __forceinline__ void operator()(const f32x4 (&acc)[2][2][4][2], const Unit& u, int wr, int wc, int fr, int fq) const {
        const int row0 = u.pm * BM + wr * 64 + fr, col0 = u.pn * BM + wc * 32 + 4 * fq;
#pragma unroll
        for (int ai = 0; ai < 2; ++ai)
#pragma unroll
            for (int m = 0; m < 4; ++m) { float* orow = out + (size_t)(row0 + ai * HALF + m * 16) * DM + col0;
#pragma unroll
                for (int bj = 0; bj < 2; ++bj)
#pragma unroll
                    for (int n = 0; n < 2; ++n) { f32x4* p = (f32x4*)(orow + bj * HALF + n * 16); *p = *p + acc[ai][bj][m][n]; } }
    }
};
struct KvOrder {
    int c;
    __device__ bool next(int i, Unit& u) const { if (i != 0 || c < 0 || c >= 16) return false; u.pm = c >> 3; u.pn = c & 7; return true; }
    __device__ __forceinline__ void a_ready(const Unit&) const {}
    __device__ __forceinline__ void done(const Unit&) const {}
};
}

__device__ __forceinline__ v4u ldg16(const unsigned char* ubase, unsigned off) { return *(const v4u*)(ubase + off); }
__device__ __forceinline__ void stg16(unsigned char* ubase, unsigned off, v4u v) { *(v4u*)(ubase + off) = v; }
__device__ __forceinline__ void win_map(int drow, int& src, int& nvalid, float& scale) {
    nvalid = 32; scale = 1.f;
    if (drow < 4096) { src = drow; if (drow < 1024) scale = 0.0625f; }
    else if (drow < 10240) { src = drow + 16; if (drow >= ZXQ) scale = 0.0625f; }
    else if (drow == 10240) { src = 4096; nvalid = 16; }
    else if (drow < 10496) { src = 0; nvalid = 0; }
    else src = drow - 240;
}
__device__ __forceinline__ void ph0_prologue(Frame& F) {
    int tid_ = threadIdx.x; asm volatile("" : "+v"(tid_)); const int tid = tid_, lane = tid & 63; (void)lane;
    LAS float* scr = (LAS float*)(F.lds + F.wave * 16384);
    const int gw = F.vcu * NWAVES + F.wave, NGW = F.G * NWAVES;
    bf16* Wint = (bf16*)(F.ws + WS_RA); bf16* Wbr = (bf16*)(F.ws + WS_WBR); bf16* Wout = (bf16*)(F.ws + WS_WOUT); bf16* Wkv = (bf16*)(F.ws + WS_WKV);
    constexpr int I_IN = (NIN_T / 32) * 64, I_GLA = 128 * 32, I_CV = 128 * 16, I_XA = 128 * 16, I_OUT = 128 * 64, I_KV = 64 * 64;
    constexpr int NITEMS = I_IN + I_GLA + I_CV + I_XA + I_OUT + I_KV;
    for (int it = gw; it < NITEMS; it += NGW) {
        int r = it;
        if (r < I_IN) { const int nb = r >> 6, kb = r & 63; int src, nv; float sc; win_map(nb * 32, src, nv, sc);
            tr_item(F.in[I_WIN] + (size_t)(kb * 64) * IN_COLS + src, IN_COLS, nv, sc, Wint + (size_t)(nb * 32) * DM + kb * 64, DM, scr, lane); continue; } r -= I_IN;
        if (r < I_GLA) { const int nb = r >> 5, kb = r & 31;
            tr_item(F.in[I_WGLAO] + (size_t)(kb * 64) * DM + nb * 32, DM, 32, 1.f, Wbr + (size_t)(nb * 32) * DM + kb * 64, DM, scr, lane); continue; } r -= I_GLA;
        if (r < I_CV) { const int nb = r >> 4, kb = r & 15;
            tr_item(F.in[I_WCONVO] + (size_t)(kb * 64) * DM + nb * 32, DM, 32, 1.f, Wbr + (size_t)(nb * 32) * DM + 2048 + kb * 64, DM, scr, lane); continue; } r -= I_CV;
        if (r < I_XA) { const int nb = r >> 4, kb = r & 15;
            tr_item(F.in[I_WXAO] + (size_t)(kb * 64) * DM + nb * 32, DM, 32, 1.f, Wbr + (size_t)(nb * 32) * DM + 3072 + kb * 64, DM, scr, lane); continue; } r -= I_XA;
        if (r < I_OUT) { const int nb = r >> 6, kb = r & 63;
            tr_item(F.in[I_WOUT] + (size_t)(kb * 64) * DM + nb * 32, DM, 32, 1.f, Wout + (size_t)(nb * 32) * DM + kb * 64, DM, scr, lane); continue; } r -= I_OUT;
        { const int nb = r >> 6, kb = r & 63;
            tr_item(F.in[I_WMEMKV] + (size_t)(kb * 64) * 2048 + nb * 32, 2048, 32, 1.f, Wkv + (size_t)(nb * 32) * DM + kb * 64, DM, scr, lane); }
    }
    bf16* xn = (bf16*)((unsigned char*)F.out + OY_XN); bf16* memn = (bf16*)(F.ws + WS_MEMN);
    for (int m = gw; m < T + 512; m += NGW) {
        if (m < T) rms_row_to_bf16(xrow_ptr(F, m), F.in[I_GMIX], xn + (size_t)m * DM, lane);
        else rms_row_to_bf16(F.in[I_MEMP] + (size_t)(m - T) * DM, F.in[I_GMEM], memn + (size_t)(m - T) * DM, lane);
    }
    bf16* mkv = (bf16*)(F.ws + WS_MKV);
    const int gt = F.vcu * NTHR + tid, NGT = F.G * NTHR;
    for (int i = gt; i < 2 * 32 * 256 * 256; i += NGT) {
        const int which = i >> 21, rem = i & ((1 << 21) - 1), row = rem >> 8, c4 = rem & 255;
        const f32x4 v = *((const f32x4*)(F.in[which ? I_CMV : I_CMK]) + (size_t)row * 256 + c4);
        v2u w; w.x = pk2(v.x, v.y); w.y = pk2(v.z, v.w);
        *(v2u*)(mkv + (size_t)(512 + row) * 2048 + which * 1024 + c4 * 4) = w;
    }
}

__device__ __forceinline__ void ph_g0(Frame& F) {
    int tid_ = threadIdx.x; asm volatile("" : "+v"(tid_)); const int tid = tid_, lane = tid & 63; (void)lane;
    bf16* zs = (bf16*)(F.ws + WS_ZS); const float* alr = (const float*)(F.ws + WS_ALR); float* Aout = (float*)(F.ws + WS_AOUT);
    LAS float* alr_s = (LAS float*)F.lds; LAS float* tot = alr_s + 64 * 16;
    const int c = tid & 127, tg = tid >> 7;
    for (int unit = F.vcu; unit < NCHK * 8; unit += F.G) {
        const int ci = unit >> 3, ch = (unit & 7) * 128 + c;
        __syncthreads();
        if (tid < 256) *(LAS f32x4*)(alr_s + tid * 4) = *(const f32x4*)(alr + (size_t)ci * 64 * RANK + tid * 4);
        float w[16];
#pragma unroll
        for (int r = 0; r < 16; ++r) w[r] = F.in[I_WA2][r * GK + ch];
        const float ba = F.in[I_BA][ch];
        __syncthreads();
        float Bl[16]; float run = 0.f;
#pragma unroll
        for (int tt = 0; tt < 16; ++tt) { const LAS float* ar = alr_s + (tg * 16 + tt) * 16; float x = ba;
#pragma unroll
            for (int r = 0; r < 16; ++r) x += ar[r] * w[r];
            const float ls = fminf(x, 0.f) - log1pf(__expf(-fabsf(x)));
            run += ls * 0.0625f; Bl[tt] = run; }
        tot[tg * 128 + c] = run;
        __syncthreads();
        float off = 0.f, blast = 0.f;
#pragma unroll
        for (int g = 0; g < 4; ++g) { const float tv = tot[g * 128 + c]; blast += tv; if (g < tg) off += tv; }
#pragma unroll
        for (int tt = 0; tt < 16; ++tt) { const float B = Bl[tt] + off; const size_t row = (size_t)ci * 64 + tg * 16 + tt;
            bf16* qp = zs + row * ZS_LD + ZQ + ch; bf16* kp = zs + row * ZS_LD + ZK + ch;
            *qp = f2bf1(bf1(*qp) * __expf(B)); *kp = f2bf1(bf1(*kp) * __expf(-B)); }
        if (tg == 0) Aout[(size_t)ci * GK + ch] = __expf(blast);
    }
}
__device__ __forceinline__ void ph_conv(Frame& F) {
    int tid_ = threadIdx.x; asm volatile("" : "+v"(tid_)); const int tid = tid_, lane = tid & 63; (void)lane;
    const bf16* zs = (const bf16*)(F.ws + WS_ZS); bf16* br = (bf16*)((unsigned char*)F.out + OY_BR);
    const int gt = F.vcu * NTHR + tid, NGT = F.G * NTHR;
    for (int item = gt; item < T * 128; item += NGT) {
        const int row = item >> 7, c8 = (item & 127) * 8;
        int t, Tlen, sb; if (row < TP) { t = row & (SEQP - 1); Tlen = SEQP; sb = -1; } else { t = (row - TP) & 63; Tlen = 64; sb = (row - TP) >> 6; }
        float u[3][8];
#pragma unroll
        for (int d = 0; d < 3; ++d) {
            if (t - d >= 0) { float a[8], b[8]; unpack8(*(const v4u*)(zs + (size_t)(row - d) * ZS_LD + ZCC + c8), a); unpack8(*(const v4u*)(zs + (size_t)(row - d) * ZS_LD + ZCH + c8), b);
#pragma unroll
                for (int j = 0; j < 8; ++j) u[d][j] = a[j] * b[j]; }
            else if (sb >= 0) { const float* bp = F.in[I_CCONV] + ((size_t)sb * 2 + (t - d + 2)) * CW + c8;
#pragma unroll
                for (int j = 0; j < 8; ++j) u[d][j] = bp[j]; }
            else {
#pragma unroll
                for (int j = 0; j < 8; ++j) u[d][j] = 0.f; }
        }
        float cb[8], o[8]; unpack8(*(const v4u*)(zs + (size_t)row * ZS_LD + ZCB + c8), cb);
        const float* wc = F.in[I_WCONV] + c8;
#pragma unroll
        for (int j = 0; j < 8; ++j) o[j] = cb[j] * (u[2][j] * wc[j] + u[1][j] * wc[CW + j] + u[0][j] * wc[2 * CW + j]);
        *(v4u*)(br + (size_t)row * DM + 2048 + c8) = pack8(o);
        if (t >= Tlen - 2) { float* ob = (sb < 0) ? F.out + O_CCP + ((size_t)(row >> 13) * 2 + (t - (Tlen - 2))) * CW + c8 : F.out + O_CCS + ((size_t)sb * 2 + (t - (Tlen - 2))) * CW + c8;
#pragma unroll
            for (int j = 0; j < 8; ++j) ob[j] = u[0][j]; }
    }
}
__device__ __forceinline__ void ph_g1(Frame& F) {
    int tid_ = threadIdx.x; asm volatile("" : "+v"(tid_)); const int tid = tid_;
    LAS unsigned char* kin_s = F.lds; LAS unsigned char* v_s = F.lds + 32768;
    const int i = tid >> 5, j = tid & 31, dk0 = 16 * i;
    const unsigned kld = (unsigned)((tid >> 5) * (ZS_LD * 2) + (tid & 31) * 16), klds = (unsigned)((tid >> 5) * 512 + (tid & 31) * 16);
    const unsigned vld = (unsigned)((tid >> 6) * (ZS_LD * 2) + (tid & 63) * 16), vlds = (unsigned)((tid >> 6) * 1024 + (tid & 63) * 16);
    for (int unit = F.vcu; unit < NCHK * NH; unit += F.G) {
        const int ci = unit >> 2, h = unit & 3;
        const unsigned char* zc = F.ws + WS_ZS + (size_t)ci * 64 * ZS_LD * 2;
        __syncthreads();
#pragma unroll
        for (int q = 0; q < 4; ++q) *(LAS v4u*)(kin_s + klds + q * 16 * 512) = ldg16(zc + (ZK + h * DK) * 2, kld + q * 16 * ZS_LD * 2);
#pragma unroll
        for (int q = 0; q < 8; ++q) *(LAS v4u*)(v_s + vlds + q * 8 * 1024) = ldg16(zc + (ZV + h * DV) * 2, vld + q * 8 * ZS_LD * 2);
        __syncthreads();
        unsigned char* slot = (unsigned char*)slot_ptr(F, ci, h);
        const float* Ap = (const float*)(F.ws + WS_AOUT) + (size_t)ci * GK + h * DK;
#pragma unroll 1
        for (int pass = 0; pass < 4; ++pass) {
            const int dv0 = (pass >> 1) * 256 + 8 * j, dkk = dk0 + 8 * (pass & 1);
            float acc[8][8];
#pragma unroll
            for (int a = 0; a < 8; ++a)
#pragma unroll
                for (int b = 0; b < 8; ++b) acc[a][b] = 0.f;
#pragma unroll 2
            for (int s = 0; s < 64; ++s) {
                float k0[8], vv[8];
                unpack8(*(const LAS v4u*)(kin_s + s * 512 + dkk * 2), k0); unpack8(*(const LAS v4u*)(v_s + s * 1024 + dv0 * 2), vv);
#pragma unroll
                for (int a = 0; a < 8; ++a)
#pragma unroll
                    for (int b = 0; b < 8; ++b) acc[a][b] += k0[a] * vv[b];
            }
            const unsigned so = (unsigned)(dkk * DV + dv0) * 2u;
#pragma unroll
            for (int a = 0; a < 8; ++a) { const float A = Ap[dkk + a]; float o[8];
#pragma unroll
                for (int b = 0; b < 8; ++b) o[b] = acc[a][b] * A;
                stg16(slot, so + a * (DV * 2), pack8(o)); }
        }
    }
}
__device__ __forceinline__ void ph_xattn(Frame& F) {
    int tid_ = threadIdx.x; asm volatile("" : "+v"(tid_)); const int tid = tid_, lane = tid & 63;
    constexpr int XS = 528, MS = 272;
    LAS unsigned char* xq_s = F.lds; LAS unsigned char* mk_s = F.lds + 64 * XS; LAS float* P_s = (LAS float*)mk_s;
    const int i = F.wave, j = lane;
    const unsigned qld = (unsigned)((tid >> 5) * (ZS_LD * 2) + (tid & 31) * 16), qlds = (unsigned)((tid >> 5) * XS + (tid & 31) * 16);
    const unsigned mld = (unsigned)((tid >> 4) * 4096 + (tid & 15) * 16), mlds = (unsigned)((tid >> 4) * MS + (tid & 15) * 16);
    for (int unit = F.vcu; unit < NCHK * NH; unit += F.G) {
        const int ci = unit >> 2, h = unit & 3; int seq, cis; chunk_seq(ci, seq, cis);
        const unsigned char* zc = F.ws + WS_ZS + (size_t)ci * 64 * ZS_LD * 2 + (ZXQ + h * XDH) * 2;
        const unsigned char* kb = F.ws + WS_MKV + ((size_t)seq * 256 * 2048 + h * XDH) * 2; const unsigned char* vb = kb + 2048;
        __syncthreads();
#pragma unroll
        for (int q = 0; q < 4; ++q) *(LAS v4u*)(xq_s + qlds + q * 16 * XS) = ldg16(zc, qld + q * 16 * ZS_LD * 2);
        float sc[8][4];
#pragma unroll
        for (int a = 0; a < 8; ++a)
#pragma unroll
            for (int b = 0; b < 4; ++b) sc[a][b] = 0.f;
#pragma unroll 1
        for (int half = 0; half < 2; ++half) {
            __syncthreads();
#pragma unroll
            for (int q = 0; q < 8; ++q) *(LAS v4u*)(mk_s + mlds + q * 32 * MS) = ldg16(kb + half * 256, mld + q * 32 * 4096);
            __syncthreads();
#pragma unroll 1
            for (int d8 = 0; d8 < 16; ++d8) {
                float kk[4][8];
#pragma unroll
                for (int b = 0; b < 4; ++b) unpack8(*(const LAS v4u*)(mk_s + (4 * j + b) * MS + d8 * 16), kk[b]);
#pragma unroll
                for (int a = 0; a < 8; ++a) { float qq[8]; unpack8(*(const LAS v4u*)(xq_s + (8 * i + a) * XS + half * 256 + d8 * 16), qq);
#pragma unroll
                    for (int b = 0; b < 4; ++b)
#pragma unroll
                        for (int e = 0; e < 8; ++e) sc[a][b] += qq[e] * kk[b][e]; }
            }
        }
#pragma unroll
        for (int a = 0; a < 8; ++a) {
            float mx = fmaxf(fmaxf(sc[a][0], sc[a][1]), fmaxf(sc[a][2], sc[a][3])); mx = wave_max(mx);
            float sm = 0.f;
#pragma unroll
            for (int b = 0; b < 4; ++b) { sc[a][b] = __expf(sc[a][b] - mx); sm += sc[a][b]; }
            sm = wave_sum(sm); const float inv = 1.f / sm;
#pragma unroll
            for (int b = 0; b < 4; ++b) sc[a][b] *= inv;
        }
        __syncthreads();
#pragma unroll
        for (int a = 0; a < 8; ++a) *(LAS f32x4*)(P_s + (8 * i + a) * 256 + 4 * j) = (f32x4){sc[a][0], sc[a][1], sc[a][2], sc[a][3]};
        __syncthreads();
        float o[8][4];
#pragma unroll
        for (int a = 0; a < 8; ++a)
#pragma unroll
            for (int b = 0; b < 4; ++b) o[a][b] = 0.f;
        const unsigned vo = (unsigned)j * 8u;
#pragma unroll 2
        for (int m4 = 0; m4 < 64; ++m4) {
            float vv[4][4];
#pragma unroll
            for (int e = 0; e < 4; ++e) { const v2u w = *(const v2u*)(vb + (size_t)(4 * m4 + e) * 4096 + vo); vv[e][0] = bf_lo(w.x); vv[e][1] = bf_hi(w.x); vv[e][2] = bf_lo(w.y); vv[e][3] = bf_hi(w.y); }
#pragma unroll
            for (int a = 0; a < 8; ++a) { const f32x4 p = *(const LAS f32x4*)(P_s + (8 * i + a) * 256 + 4 * m4);
#pragma unroll
                for (int e = 0; e < 4; ++e)
#pragma unroll
                    for (int b = 0; b < 4; ++b) o[a][b] += p[e] * vv[e][b]; }
        }
        unsigned char* bp = (unsigned char*)F.out + OY_BR + ((size_t)ci * 64 + 8 * i) * (DM * 2) + (3072 + h * XDH) * 2;
#pragma unroll
        for (int a = 0; a < 8; ++a) { v2u w; w.x = pk2(o[a][0], o[a][1]); w.y = pk2(o[a][2], o[a][3]);
            *(v2u*)(bp + (size_t)a * (DM * 2) + vo) = w; }
    }
}
__device__ __forceinline__ void ph_g2(Frame& F) {
    int tid_ = threadIdx.x; asm volatile("" : "+v"(tid_)); const int tid = tid_, lane = tid & 63; (void)lane;
    const float* Aout = (const float*)(F.ws + WS_AOUT);
    const int gt = F.vcu * NTHR + tid, NGT = F.G * NTHR;
    for (int item = gt; item < 2 * NH * DK * 64; item += NGT) {
        const int dv8 = item & 63, dk = (item >> 6) & 255, h = (item >> 14) & 3, seq = item >> 16;
        float S[8];
#pragma unroll
        for (int e = 0; e < 8; ++e) S[e] = 0.f;
        for (int c = 0; c < 128; ++c) { const int ci = seq * 128 + c;
            v4u* sp = (v4u*)(slot_ptr(F, ci, h) + (size_t)dk * DV + dv8 * 8); float d[8]; unpack8(*sp, d); *sp = pack8(S);
            const float a = Aout[(size_t)ci * GK + h * DK + dk];
#pragma unroll
            for (int e = 0; e < 8; ++e) S[e] = a * S[e] + d[e]; }
        float* op = F.out + O_SGP + ((size_t)((seq * NH + h) * DK + dk)) * DV + dv8 * 8;
        *(f32x4*)op = (f32x4){S[0], S[1], S[2], S[3]}; *(f32x4*)(op + 4) = (f32x4){S[4], S[5], S[6], S[7]};
    }
    for (int item = gt; item < 32 * NH * DK * 64; item += NGT) {
        const int dv8 = item & 63, dk = (item >> 6) & 255, h = (item >> 14) & 3, b = item >> 16; const int ci = NCHK_P + b;
        const size_t so = ((size_t)((b * NH + h) * DK + dk)) * DV + dv8 * 8;
        const f32x4 s0 = *(const f32x4*)(F.in[I_SGLA] + so), s1 = *(const f32x4*)(F.in[I_SGLA] + so + 4);
        float S[8] = {s0.x, s0.y, s0.z, s0.w, s1.x, s1.y, s1.z, s1.w};
        v4u* sp = (v4u*)(slot_ptr(F, ci, h) + (size_t)dk * DV + dv8 * 8); float d[8]; unpack8(*sp, d); *sp = pack8(S);
        const float a = Aout[(size_t)ci * GK + h * DK + dk];
#pragma unroll
        for (int e = 0; e < 8; ++e) S[e] = a * S[e] + d[e];
        float* op = F.out + O_SGS + so;
        *(f32x4*)op = (f32x4){S[0], S[1], S[2], S[3]}; *(f32x4*)(op + 4) = (f32x4){S[4], S[5], S[6], S[7]};
    }
}
__device__ __forceinline__ void ph_g3(Frame& F) {
    int tid_ = threadIdx.x; asm volatile("" : "+v"(tid_)); const int tid = tid_, lane = tid & 63;
    constexpr int QS = 528;
    LAS unsigned char* q_s = F.lds; LAS unsigned char* k_s = F.lds + 64 * QS; LAS float* P_s = (LAS float*)(F.lds + 2 * 64 * QS);
    const int i = F.wave, j = lane;
    const unsigned ldoff = (unsigned)((tid >> 5) * (ZS_LD * 2) + (tid & 31) * 16);
    const unsigned ldsoff = (unsigned)((tid >> 5) * QS + (tid & 31) * 16);
    for (int unit = F.vcu; unit < NCHK * NH; unit += F.G) {
        const int ci = unit >> 2, h = unit & 3;
        const unsigned char* zc = F.ws + WS_ZS + (size_t)ci * 64 * ZS_LD * 2;
        __syncthreads();
#pragma unroll
        for (int q = 0; q < 4; ++q) {
            *(LAS v4u*)(q_s + ldsoff + q * 16 * QS) = ldg16(zc + (ZQ + h * DK) * 2, ldoff + q * 16 * ZS_LD * 2);
            *(LAS v4u*)(k_s + ldsoff + q * 16 * QS) = ldg16(zc + (ZK + h * DK) * 2, ldoff + q * 16 * ZS_LD * 2); }
        __syncthreads();
        {
            const int t = tid >> 3, s0 = (tid & 7) * 8; float p[8];
#pragma unroll
            for (int e = 0; e < 8; ++e) p[e] = 0.f;
#pragma unroll 1
            for (int d8 = 0; d8 < 32; ++d8) { float qq[8]; unpack8(*(const LAS v4u*)(q_s + t * QS + d8 * 16), qq);
#pragma unroll
                for (int e = 0; e < 8; ++e) { float kk[8]; unpack8(*(const LAS v4u*)(k_s + (s0 + e) * QS + d8 * 16), kk);
#pragma unroll
                    for (int x = 0; x < 8; ++x) p[e] += qq[x] * kk[x]; }
                __builtin_amdgcn_sched_barrier(0); }
#pragma unroll
            for (int e = 0; e < 8; ++e) P_s[t * 65 + s0 + e] = (s0 + e <= t) ? p[e] : 0.f;
        }
        __syncthreads();
        const unsigned char* Sp = (const unsigned char*)slot_ptr(F, ci, h);
        const unsigned lo16 = (unsigned)j * 16u;
        float gg[8];
        { const f32x4 g0 = *(const f32x4*)(F.in[I_GGLA] + 8 * j), g1 = *(const f32x4*)(F.in[I_GGLA] + 8 * j + 4); gg[0] = g0.x; gg[1] = g0.y; gg[2] = g0.z; gg[3] = g0.w; gg[4] = g1.x; gg[5] = g1.y; gg[6] = g1.z; gg[7] = g1.w; }
#pragma unroll 1
        for (int ah = 0; ah < 2; ++ah) {
            const int t0 = 8 * i + 4 * ah;
            float acc[4][8];
#pragma unroll
            for (int a = 0; a < 4; ++a)
#pragma unroll
                for (int b = 0; b < 8; ++b) acc[a][b] = 0.f;
#pragma unroll 1
            for (int d8 = 0; d8 < 32; ++d8) {
                v4u qp[4];
#pragma unroll
                for (int a = 0; a < 4; ++a) qp[a] = *(const LAS v4u*)(q_s + (t0 + a) * QS + d8 * 16);
#pragma unroll
                for (int e2 = 0; e2 < 4; ++e2) { float s0[8], s1[8]; unpack8(ldg16(Sp + (size_t)(d8 * 8 + 2 * e2) * (DV * 2), lo16), s0); unpack8(ldg16(Sp + (size_t)(d8 * 8 + 2 * e2 + 1) * (DV * 2), lo16), s1);
#pragma unroll
                    for (int a = 0; a < 4; ++a) { const unsigned w = qp[a][e2]; const float q0 = bf_lo(w), q1 = bf_hi(w);
#pragma unroll
                        for (int b = 0; b < 8; ++b) acc[a][b] += q0 * s0[b] + q1 * s1[b]; } }
                __builtin_amdgcn_sched_barrier(0);
            }
            const unsigned char* vp = zc + (ZV + h * DV) * 2;
#pragma unroll 2
            for (int s = 0; s < t0 + 4; ++s) {
                float vv[8]; unpack8(ldg16(vp + (size_t)s * (ZS_LD * 2), lo16), vv);
#pragma unroll
                for (int a = 0; a < 4; ++a) { const float p = P_s[(t0 + a) * 65 + s];
#pragma unroll
                    for (int b = 0; b < 8; ++b) acc[a][b] += p * vv[b]; }
                __builtin_amdgcn_sched_barrier(0);
            }
            const unsigned char* rp = zc + (size_t)t0 * (ZS_LD * 2) + (ZR + h * DV) * 2;
            unsigned char* bp = (unsigned char*)F.out + OY_BR + ((size_t)ci * 64 + t0) * (DM * 2) + (h * DV) * 2;
#pragma unroll
            for (int a = 0; a < 4; ++a) { float ss = 0.f;
#pragma unroll
                for (int b = 0; b < 8; ++b) ss += acc[a][b] * acc[a][b];
                ss = wave_sum(ss); const float rstd = rsqrtf(ss * (1.f / DV) + EPS);
                float rr[8], o[8]; unpack8(ldg16(rp + (size_t)a * (ZS_LD * 2), lo16), rr);
#pragma unroll
                for (int b = 0; b < 8; ++b) o[b] = acc[a][b] * rstd * gg[b] * (rr[b] * sigmoidf_(rr[b]));
                *(v4u*)(bp + (size_t)a * (DM * 2) + lo16) = pack8(o); }
        }
    }
}
__device__ __forceinline__ void ph8_hn_ffnw(Frame& F) {
    int tid_ = threadIdx.x; asm volatile("" : "+v"(tid_)); const int tid = tid_, lane = tid & 63; (void)lane;
    LAS float* scr = (LAS float*)(F.lds + F.wave * 16384);
    const int gw = F.vcu * NWAVES + F.wave, NGW = F.G * NWAVES;
    bf16* Wgu = (bf16*)(F.ws + WS_RA); bf16* Wdn = (bf16*)(F.ws + WS_WDN); bf16* hn = (bf16*)(F.ws + WS_HN);
    constexpr int I_GU = (NGU_T / 32) * 64, I_DN = 128 * 172;
    for (int it = gw; it < I_GU + I_DN; it += NGW) {
        int r = it;
        if (r < I_GU) { const int nb = r >> 6, kb = r & 63, drow = nb * 32, tl = drow >> 8, w = drow & 255;
            const float* W = (w < 128) ? F.in[I_WFG] : F.in[I_WFU]; const int src = tl * 128 + (w & 127);
            tr_item(W + (size_t)(kb * 64) * DFF + src, DFF, 32, 1.f, Wgu + (size_t)drow * DM + kb * 64, DM, scr, lane); continue; } r -= I_GU;
        { const int nb = r / 172, kb = r % 172;
            tr_item(F.in[I_WFD] + (size_t)(kb * 64) * DM + nb * 32, DM, 32, 1.f, Wdn + (size_t)(nb * 32) * DFF + kb * 64, DFF, scr, lane); }
    }
    for (int m = gw; m < T; m += NGW) rms_row_to_bf16(F.out + (size_t)m * DM, F.in[I_GFFN], hn + (size_t)m * DM, lane);
}
__device__ __forceinline__ void ph11_final(Frame& F) {
    int tid_ = threadIdx.x; asm volatile("" : "+v"(tid_)); const int tid = tid_, lane = tid & 63; (void)lane;
    const int gw = F.vcu * NWAVES + F.wave, NGW = F.G * NWAVES;
    for (int m = gw; m < T; m += NGW) {
        f32x4* xr = (f32x4*)(F.out + (size_t)m * DM) + lane; const f32x4* gr = (const f32x4*)F.in[I_GFINAL] + lane;
        f32x4 v[16]; float s = 0.f;
#pragma unroll
        for (int j = 0; j < 16; ++j) { v[j] = xr[64 * j]; s += (v[j].x * v[j].x + v[j].y * v[j].y) + (v[j].z * v[j].z + v[j].w * v[j].w); }
        const float rstd = rsqrtf(wave_sum(s) * (1.f / DM) + EPS);
#pragma unroll
        for (int j = 0; j < 16; ++j) xr[64 * j] = v[j] * rstd * gr[64 * j];
    }
}

#ifndef MK_ONE_LAUNCH
#define MK_ONE_LAUNCH 1
#endif
constexpr int N_PHASES = 12;
struct Args { const float* in[25]; float* out; unsigned char* ws; int ph_lo, ph_hi; };
__global__ void __launch_bounds__(NTHR, 2) fwd_kernel(Args args) {
    extern __shared__ __attribute__((aligned(16))) unsigned char lds[];
    Frame F;
    F.lds = (LAS unsigned char*)lds;
    F.wave = __builtin_amdgcn_readfirstlane((int)threadIdx.x >> 6);
    F.G = gridDim.x; { const int bx = blockIdx.x; F.vcu = (F.G % 8 == 0) ? (bx % 8) * (F.G / 8) + bx / 8 : bx; }
#pragma unroll
    for (int i = 0; i < 25; ++i) F.in[i] = args.in[i];
    F.out = args.out; F.ws = args.ws;
    volatile LAS unsigned* MISC = (volatile LAS unsigned*)(F.lds + MISC_OFF);
    for (int u = threadIdx.x; u < (LDS_BYTES - LDSCTL_OFF) / 4; u += NTHR) ((LAS unsigned*)(F.lds + LDSCTL_OFF))[u] = 0u;
    __syncthreads();
    const int lo = args.ph_lo, hi = args.ph_hi;
    XcdBarrier bar; bar.bar = (unsigned*)(F.ws + WS_CTL) + CW_BAR; bar.x = 0; bar.st = nullptr;
    if (hi - lo > 1) bar = xcd_barrier_post((unsigned*)(F.ws + WS_CTL) + CW_BAR, MISC + 8);
#ifndef PH_MASK
#define PH_MASK 0xfff
#endif
#define IN(k) (((PH_MASK >> (k)) & 1) && lo <= (k) && (k) < hi)
#define SEAM(k) do { if (lo <= (k) && (k) + 1 < hi) xcd_barrier(bar); } while (0)

    if (IN(0)) { ph0_prologue(F); } SEAM(0);

    if (IN(1)) {
        { pg8::Gemm g{(const bf16*)(F.ws + WS_MEMN), (const bf16*)(F.ws + WS_WKV), 512, 2048, DM}; pg8::KvOrder S{(int)blockIdx.x - 8};
          pg8::EpiKV E{F.out + O_MKP, F.out + O_MVP, (bf16*)(F.ws + WS_MKV)};
          pg8::gemm_phase<pg8::EpiKV, pg8::KvOrder, true, true>(F.lds, g, S, E); }
        { pg8::Gemm g{(const bf16*)((unsigned char*)F.out + OY_XN), (const bf16*)(F.ws + WS_RA), T, NIN_T, DM}; pg8::StaticOrder S; S.init(T, NIN_T, F.G, (int)blockIdx.x);
          pg8::EpiZ E{(bf16*)(F.ws + WS_ZS), (float*)(F.ws + WS_ALR), (bf16*)(F.ws + WS_GATES), F.in[I_BMERGE]};
          pg8::gemm_phase<pg8::EpiZ, pg8::StaticOrder, true, true>(F.lds, g, S, E); }
    } SEAM(1);

    if (IN(2)) { ph_g0(F); ph_conv(F); } SEAM(2);
    if (IN(3)) { ph_g1(F); ph_xattn(F); } SEAM(3);
    if (IN(4)) { ph_g2(F); } SEAM(4);
    if (IN(5)) { ph_g3(F); } SEAM(5);

    if (IN(6)) {
        pg8::Gemm g{(const bf16*)((unsigned char*)F.out + OY_BR), (const bf16*)(F.ws + WS_WBR), T, DM, DM}; pg8::StaticOrder S; S.init(T, DM, F.G, (int)blockIdx.x);
        pg8::EpiMix E{(const bf16*)(F.ws + WS_GATES), (bf16*)(F.ws + WS_MIX)};
        pg8::gemm_phase<pg8::EpiMix, pg8::StaticOrder, true, true>(F.lds, g, S, E);
    } SEAM(6);

    if (IN(7)) {
        pg8::Gemm g{(const bf16*)(F.ws + WS_MIX), (const bf16*)(F.ws + WS_WOUT), T, DM, DM}; pg8::StaticOrder S; S.init(T, DM, F.G, (int)blockIdx.x);
        pg8::EpiX1 E{F.in[I_XP], F.in[I_XS], F.out};
        pg8::gemm_phase<pg8::EpiX1, pg8::StaticOrder, true, true>(F.lds, g, S, E);
    } SEAM(7);

    if (IN(8)) { ph8_hn_ffnw(F); } SEAM(8);

    if (IN(9)) {
        pg8::Gemm g{(const bf16*)(F.ws + WS_HN), (const bf16*)(F.ws + WS_RA), T, NGU_T, DM}; pg8::StaticOrder S; S.init(T, NGU_T, F.G, (int)blockIdx.x);
        pg8::EpiGU E{(bf16*)(F.ws + WS_GATES)};
        pg8::gemm_phase<pg8::EpiGU, pg8::StaticOrder, true, true>(F.lds, g, S, E);
    } SEAM(9);

    if (IN(10)) {
        pg8::Gemm g{(const bf16*)(F.ws + WS_GATES), (const bf16*)(F.ws + WS_WDN), T, DM, DFF}; pg8::StaticOrder S; S.init(T, DM, F.G, (int)blockIdx.x);
        pg8::EpiDown E{F.out};
        pg8::gemm_phase<pg8::EpiDown, pg8::StaticOrder, true, true>(F.lds, g, S, E);
    } SEAM(10);

    if (IN(11)) { ph11_final(F); }
#undef IN
#undef SEAM
}

extern "C" void kernel_launch(void* const* d_in, const int* in_sizes, int n_in, void* d_out, int out_size, void* d_ws, size_t ws_size, hipStream_t stream) {
    static int grid = 0;
    if (grid == 0) {
        if (n_in != 25 || in_sizes[0] != TP * DM || out_size != 94441472 || ws_size < WS_END) { fprintf(stderr, "kernel_launch: unexpected problem shape (n_in %d, out %d, ws %zu); nothing launched\n", n_in, out_size, ws_size); grid = -1; return; }
        int dev = 0, cus = 0, per_cu = 0;
        if (hipGetDevice(&dev) != hipSuccess || hipDeviceGetAttribute(&cus, hipDeviceAttributeMultiprocessorCount, dev) != hipSuccess) { grid = -1; return; }
        if (hipFuncSetAttribute((const void*)fwd_kernel, hipFuncAttributeMaxDynamicSharedMemorySize, LDS_BYTES) != hipSuccess) { fprintf(stderr, "kernel_launch: hipFuncSetAttribute failed\n"); grid = -1; return; }
        if (hipOccupancyMaxActiveBlocksPerMultiprocessor(&per_cu, (const void*)fwd_kernel, NTHR, LDS_BYTES) != hipSuccess || per_cu < 1) { fprintf(stderr, "kernel_launch: occupancy query says %d blocks per CU\n", per_cu); }
        (void)hipGetLastError();
        grid = cus;
    }
    if (grid < 0) return;
    if (hipMemsetAsync((char*)d_ws + WS_CTL, 0, CTL_ZERO_BYTES, stream) != hipSuccess) return;
    Args a{};
    for (int i = 0; i < 25; ++i) a.in[i] = (const float*)d_in[i];
    a.out = (float*)d_out; a.ws = (unsigned char*)d_ws;
#if MK_ONE_LAUNCH
    a.ph_lo = 0; a.ph_hi = N_PHASES;
    hipLaunchKernelGGL(fwd_kernel, dim3(grid), dim3(NTHR), LDS_BYTES, stream, a);
#else
    for (int p = 0; p < N_PHASES; ++p) { a.ph_lo = p; a.ph_hi = p + 1; hipLaunchKernelGGL(fwd_kernel, dim3(grid), dim3(NTHR), LDS_BYTES, stream, a); }
#endif
}
```

```cpp
#include <hip/hip_runtime.h>
#include <cstdio>
#include <cstdint>

namespace pg8 {
#define PG8_LAS __attribute__((address_space(3)))
typedef unsigned short bf16_t;
typedef short bf16x8 __attribute__((ext_vector_type(8)));
typedef float f32x4 __attribute__((ext_vector_type(4)));
typedef unsigned u32x4 __attribute__((ext_vector_type(4)));
constexpr int BM = 256, BK = 64, HALF = 128, HTB = HALF * BK * 2  , STAGE_BYTES = 8 * HTB, NXCD = 8, WGM = 8;

__host__ __device__ __forceinline__ int lds_byte(int r, int c) { const int st = (r >> 4) * 2 + (c >> 5), rr = r & 15, cc = c & 31, ob = rr * 64 + cc * 2; return st * 1024 + (ob ^ (((ob >> 9) & 1) << 5)); }
__host__ __device__ __forceinline__ void stage_rc(int b, int& R, int& C) { const int st = b / 1024, sb = b % 1024, swz = sb ^ (((sb >> 9) & 1) << 5); R = (st >> 1) * 16 + swz / 64; C = (st & 1) * 32 + (swz % 64) / 2; }
__host__ __device__ __forceinline__ int perm32(int rho) { const int n = rho >> 4, i = rho & 15; return 8 * (i >> 2) + 4 * n + (i & 3); }

struct Unit { int pm, pn, prob; const char* a; const char* b; };

struct Prob { const char* A; const char* B; int nM, nN; };
struct MultiOrder {
    Prob p[4]; int np, G, c; size_t tstep;
    __host__ __device__ void init(int K, int G_, int c_) { np = 0; G = G_; c = c_; tstep = (size_t)BM * K * 2; }
    __host__ __device__ void add(const void* A, const void* B, int M, int N) { p[np].A = (const char*)A; p[np].B = (const char*)B; p[np].nM = M / BM; p[np].nN = N / BM; ++np; }
    __host__ __device__ bool next(int i, Unit& u) const {
        long L = (long)i * G + c; if (c < 0) return false;
#pragma unroll
        for (int q = 0; q < 4; ++q) { if (q >= np) break;
            const int nM = p[q].nM, nN = p[q].nN, nwg = nM * nN;
            if (L < nwg) {
                int wgid = (int)L; { const int qq = nwg / NXCD, r = nwg % NXCD, xcd = wgid % NXCD, off = wgid / NXCD; wgid = (xcd < r ? xcd * (qq + 1) : r * (qq + 1) + (xcd - r) * qq) + off; }
                const int nig = WGM * nN, gid = wgid / nig, fm = gid * WGM, gsz = (nM - fm) < WGM ? (nM - fm) : WGM;
                u.pm = fm + ((wgid % nig) % gsz); u.pn = (wgid % nig) / gsz; u.prob = q;
                u.a = p[q].A + (size_t)u.pm * tstep; u.b = p[q].B + (size_t)u.pn * tstep; return true; }
            L -= nwg; }
        return false;
    }
    __device__ __forceinline__ void a_ready(const Unit&) const {}
    __device__ __forceinline__ void done(const Unit&) const {}
};
struct StaticOrder : MultiOrder {
    __host__ __device__ void init1(const void* A, const void* B, int M, int N, int K, int G_, int c_) { init(K, G_, c_); add(A, B, M, N); }
};

typedef __bf16 bf16x2_t __attribute__((ext_vector_type(2)));
typedef float f32x2_t __attribute__((ext_vector_type(2)));
__device__ __forceinline__ unsigned cvt_pk_bf16(float lo, float hi) { const f32x2_t f = {lo, hi}; const bf16x2_t b = __builtin_convertvector(f, bf16x2_t); return __builtin_bit_cast(unsigned, b); }

template <class Epi, class Sched, bool ALIGN_EPI = false, bool SP2 = false>
__device__ __forceinline__ void gemm_phase(PG8_LAS unsigned char* lds, const int K, const Sched& S, const Epi& E) {
    int tid_ = threadIdx.x; asm volatile("" : "+v"(tid_)); const int tid = tid_, wid = __builtin_amdgcn_readfirstlane(tid >> 6), lane = tid & 63, wr = wid >> 2, wc = wid & 3, fr = lane & 15, fq = lane >> 4;
    const int nt = K / BK;
    unsigned voffA[2], voffB[2];
#pragma unroll
    for (int i = 0; i < 2; ++i) { int R, C; stage_rc(tid * 16 + i * 8192, R, C); const int Rb = Epi::PERM ? ((R & ~31) + perm32(R & 31)) : R;
        voffA[i] = (unsigned)(R * K + C) * 2u; voffB[i] = (unsigned)(Rb * K + C) * 2u; }
    const size_t kstep = (size_t)(BK * 2);
    const size_t hstep = (size_t)HALF * K * 2;
    const unsigned ldsw = (unsigned)wid * 1024u;
    const int aoff = lds_byte(wr * 64 + fr, fq * 8), boff = lds_byte(wc * 32 + fr, fq * 8);
#define PG8_SA(b, h) (((b) * 2 + (h)) * HTB)
#define PG8_SB(b, h) ((4 + (b) * 2 + (h)) * HTB)
#define PG8_STAGE(bufoff, gbase, voff) do { _Pragma("unroll") for (int _i = 0; _i < 2; ++_i) \
        __builtin_amdgcn_global_load_lds((const unsigned*)((const char*)(gbase) + (voff)[_i]), (PG8_LAS unsigned*)(lds + (bufoff) + ldsw + _i * 8192), 16, 0, 0); } while (0)
#define PG8_LDA(dst, b, h) do { _Pragma("unroll") for (int m = 0; m < 4; ++m) _Pragma("unroll") for (int k = 0; k < 2; ++k) dst[m][k] = *(const PG8_LAS bf16x8*)(lds + PG8_SA(b, h) + aoff + m * 2048 + k * 1024); } while (0)
#define PG8_LDB(dst, b, h) do { _Pragma("unroll") for (int n = 0; n < 2; ++n) _Pragma("unroll") for (int k = 0; k < 2; ++k) dst[n][k] = *(const PG8_LAS bf16x8*)(lds + PG8_SB(b, h) + boff + n * 2048 + k * 1024); } while (0)
#define PG8_MMA(ai, bj, At, Bt) do { __builtin_amdgcn_s_setprio(1); _Pragma("unroll") for (int m = 0; m < 4; ++m) _Pragma("unroll") for (int n = 0; n < 2; ++n) _Pragma("unroll") for (int k = 0; k < 2; ++k) \
        acc[ai][bj][m][n] = __builtin_amdgcn_mfma_f32_16x16x32_bf16(Bt[n][k], At[m][k], acc[ai][bj][m][n], 0, 0, 0); __builtin_amdgcn_s_setprio(0); } while (0)
#define PG8_WAIT_V(n) asm volatile("s_waitcnt vmcnt(" #n ")" ::: "memory")
#define PG8_WAIT_L(n) asm volatile("s_waitcnt lgkmcnt(" #n ")" ::: "memory")
#define PG8_BAR __builtin_amdgcn_s_barrier()
#define PG8_SCHED __builtin_amdgcn_sched_barrier(0)
    Unit cur, nxt; int ui = 0;
    if (!S.next(0, cur)) return;
    f32x4 acc[2][2][4][2];
#pragma unroll
    for (int a = 0; a < 2; ++a)
#pragma unroll
        for (int b = 0; b < 2; ++b)
#pragma unroll
            for (int m = 0; m < 4; ++m)
#pragma unroll
                for (int n = 0; n < 2; ++n) acc[a][b][m][n] = (f32x4){0.f, 0.f, 0.f, 0.f};
    bf16x8 At[4][2], B0[2][2], B1[2][2];
    const char* cA = cur.a; const char* cB = cur.b;
    S.a_ready(cur);
    if constexpr (SP2) {
        PG8_STAGE(PG8_SB(0, 0), cB, voffB); PG8_STAGE(PG8_SB(0, 1), cB + hstep, voffB); PG8_STAGE(PG8_SA(0, 0), cA, voffA); PG8_STAGE(PG8_SA(0, 1), cA + hstep, voffA);
        if (wr == 1) PG8_BAR;
        PG8_WAIT_V(2); PG8_BAR;
        PG8_STAGE(PG8_SB(1, 0), cB + kstep, voffB); PG8_STAGE(PG8_SA(1, 0), cA + kstep, voffA); PG8_STAGE(PG8_SB(1, 1), cB + hstep + kstep, voffB);
        PG8_WAIT_V(6); PG8_BAR;
    } else {
        PG8_STAGE(PG8_SB(0, 0), cB, voffB); PG8_STAGE(PG8_SA(0, 0), cA, voffA); PG8_STAGE(PG8_SB(0, 1), cB + hstep, voffB); PG8_STAGE(PG8_SA(0, 1), cA + hstep, voffA);
        if (wr == 1) PG8_BAR;
        PG8_WAIT_V(4); PG8_BAR;
        PG8_STAGE(PG8_SB(1, 0), cB + kstep, voffB); PG8_STAGE(PG8_SA(1, 0), cA + kstep, voffA); PG8_STAGE(PG8_SB(1, 1), cB + hstep + kstep, voffB);
        PG8_WAIT_V(6); PG8_BAR;
    }
    for (;;) {
        const bool has_next = S.next(ui + 1, nxt);
        const char* nA = has_next ? nxt.a : cA; const char* nB = has_next ? nxt.b : cB;
        for (int t = 0; t < nt; t += 2) {
            const bool last = (t == nt - 2);
            const char* a1 = cA + (size_t)(t + 1) * kstep;
            const char* a2 = last ? nA : cA + (size_t)(t + 2) * kstep; const char* b2 = last ? nB : cB + (size_t)(t + 2) * kstep;
            const char* a3 = a2 + kstep; const char* b3 = b2 + kstep;
            if (last && has_next) S.a_ready(nxt);
            if constexpr (Epi::KHOOK) { if (t == 32 || t == 48) E.khook(acc, cur, t == 32 ? 0 : 1, wr, wc, fr, fq); }
            if constexpr (SP2) {
            PG8_LDB(B0, 0, 0); PG8_LDB(B1, 0, 1); PG8_SCHED; PG8_LDA(At, 0, 0); PG8_STAGE(PG8_SA(1, 1), a1 + hstep, voffA);
            PG8_WAIT_V(8); PG8_WAIT_L(0); PG8_BAR; PG8_MMA(0, 0, At, B0); PG8_MMA(0, 1, At, B1); PG8_BAR; PG8_SCHED;
            PG8_LDA(At, 0, 1); PG8_STAGE(PG8_SB(0, 0), b2, voffB); PG8_STAGE(PG8_SB(0, 1), b2 + hstep, voffB); PG8_STAGE(PG8_SA(0, 0), a2, voffA);
            PG8_WAIT_V(8); PG8_WAIT_L(0); PG8_BAR; PG8_MMA(1, 0, At, B0); PG8_MMA(1, 1, At, B1); PG8_BAR; PG8_SCHED;
            PG8_LDB(B0, 1, 0); PG8_LDB(B1, 1, 1); PG8_SCHED; PG8_LDA(At, 1, 0); PG8_STAGE(PG8_SA(0, 1), a2 + hstep, voffA);
            PG8_WAIT_V(8); PG8_WAIT_L(0); PG8_BAR; PG8_MMA(0, 0, At, B0); PG8_MMA(0, 1, At, B1); PG8_BAR; PG8_SCHED;
            PG8_LDA(At, 1, 1); PG8_STAGE(PG8_SB(1, 0), b3, voffB); PG8_STAGE(PG8_SB(1, 1), b3 + hstep, voffB); PG8_STAGE(PG8_SA(1, 0), a3, voffA);
            PG8_WAIT_V(8); PG8_WAIT_L(0); PG8_BAR; PG8_MMA(1, 0, At, B0); PG8_MMA(1, 1, At, B1); PG8_BAR; PG8_SCHED;
            } else {
            PG8_LDB(B0, 0, 0); PG8_SCHED; PG8_LDA(At, 0, 0); PG8_STAGE(PG8_SA(1, 1), a1 + hstep, voffA);
            PG8_WAIT_L(8); PG8_BAR; PG8_WAIT_L(0); PG8_MMA(0, 0, At, B0); PG8_BAR; PG8_SCHED;
            PG8_LDB(B1, 0, 1); PG8_STAGE(PG8_SB(0, 0), b2, voffB);
            PG8_BAR; PG8_WAIT_L(0); PG8_MMA(0, 1, At, B1); PG8_BAR;
            PG8_LDA(At, 0, 1); PG8_STAGE(PG8_SA(0, 0), a2, voffA);
            PG8_BAR; PG8_WAIT_L(0); PG8_MMA(1, 0, At, B0); PG8_BAR; PG8_SCHED;
            PG8_STAGE(PG8_SB(0, 1), b2 + hstep, voffB);
            PG8_WAIT_V(6); PG8_BAR; PG8_MMA(1, 1, At, B1); PG8_BAR;
            PG8_LDB(B0, 1, 0); PG8_SCHED; PG8_LDA(At, 1, 0); PG8_STAGE(PG8_SA(0, 1), a2 + hstep, voffA);
            PG8_WAIT_L(8); PG8_BAR; PG8_WAIT_L(0); PG8_MMA(0, 0, At, B0); PG8_BAR; PG8_SCHED;
            PG8_LDB(B1, 1, 1); PG8_STAGE(PG8_SB(1, 0), b3, voffB);
            PG8_BAR; PG8_WAIT_L(0); PG8_MMA(0, 1, At, B1); PG8_BAR;
            PG8_LDA(At, 1, 1); PG8_STAGE(PG8_SA(1, 0), a3, voffA);
            PG8_BAR; PG8_WAIT_L(0); PG8_MMA(1, 0, At, B0); PG8_BAR; PG8_SCHED;
            PG8_STAGE(PG8_SB(1, 1), b3 + hstep, voffB);
            PG8_WAIT_V(6); PG8_BAR; PG8_MMA(1, 1, At, B1); PG8_BAR;
            }
        }
        if constexpr (ALIGN_EPI) { if (wr == 0) PG8_BAR; }
        E(acc, cur, wr, wc, fr, fq); S.done(cur);
        if (!has_next) break;
#pragma unroll
        for (int a = 0; a < 2; ++a)
#pragma unroll
            for (int b = 0; b < 2; ++b)
#pragma unroll
                for (int m = 0; m < 4; ++m)
#pragma unroll
                    for (int n = 0; n < 2; ++n) acc[a][b][m][n] = (f32x4){0.f, 0.f, 0.f, 0.f};
        cur = nxt; cA = nA; cB = nB; ++ui;
        if constexpr (ALIGN_EPI) { if (wr == 1) PG8_BAR; }
    }
    PG8_WAIT_V(0);
    if constexpr (!ALIGN_EPI) { if (wr == 0) PG8_BAR; }
    PG8_BAR;
#undef PG8_SA
#undef PG8_SB
#undef PG8_STAGE
#undef PG8_LDA
#undef PG8_LDB
#undef PG8_MMA
#undef PG8_WAIT_V
#undef PG8_WAIT_L
#undef PG8_BAR
#undef PG8_SCHED
}
}

constexpr int NWAVES = 8, NTHR = NWAVES * 64;
constexpr int DM = 4096, TP = 2 * 8192, TS = 32 * 64, T = TP + TS;
constexpr int SEQP = 8192, NCHK = T / 64, NCHK_P = TP / 64;
constexpr int GK = 1024, GV = 2048, DK = 256, DV = 512, NH = 4, RANK = 16;
constexpr int CW = 1024, XW = 1024, XDH = 256, NMEM = 256, DFF = 11008;
constexpr int IN_COLS = 22544;
constexpr int ZS_LD = 10240, G_LD = 12288;
constexpr int ZQ = 0, ZK = 1024, ZV = 2048, ZR = 4096, ZCB = 6144, ZCC = 7168, ZCH = 8192, ZXQ = 9216;
constexpr int NIN_T = 22784;
constexpr int NGU_T = 22016;
constexpr float EPS = 1e-6f;
constexpr size_t O_Y = 0, O_SGP = 75497472, O_CCP = 76546048, O_MKP = 76550144, O_MVP = 77074432, O_SGS = 77598720, O_CCS = 94375936;
constexpr size_t MiB = 1u << 20;
constexpr size_t WS_CTL = 0, CTL_ZERO_BYTES = 1 * MiB;
constexpr size_t WS_RA = 1 * MiB;
constexpr size_t WS_DS0 = WS_RA, WS_DSS = WS_RA + 128 * MiB;
constexpr size_t WS_WBR = 180 * MiB, WS_WOUT = 212 * MiB, WS_WKV = 244 * MiB;
constexpr size_t WS_ZS = 260 * MiB;
constexpr size_t WS_MIX = WS_ZS, WS_HN = WS_ZS + 144 * MiB;
constexpr size_t WS_GATES = 620 * MiB;
constexpr size_t WS_DS1 = 1052 * MiB;
constexpr size_t WS_MKV = 1180 * MiB;
constexpr size_t WS_ALR = 1214 * MiB, WS_MEMN = 1216 * MiB, WS_AOUT = 1220 * MiB, WS_WDN = 1222 * MiB;
constexpr size_t WS_VT = 1308 * MiB;
constexpr size_t WS_KINT = 1380 * MiB;
constexpr size_t WS_MVT = 1416 * MiB;
constexpr size_t WS_END = 1433 * MiB;
constexpr size_t OY_XN = 0, OY_BR = (size_t)T * DM * 2;

constexpr int CW_BAR = 4096;
constexpr int RING_BYTES = 131072, LDSCTL_OFF = RING_BYTES, MISC_OFF = LDSCTL_OFF + 320, LDS_BYTES = 147456;

#define GAS __attribute__((address_space(1)))
#define LAS __attribute__((address_space(3)))
typedef unsigned short bf16;
typedef unsigned v4u __attribute__((ext_vector_type(4)));
typedef unsigned v2u __attribute__((ext_vector_type(2)));
typedef float f32x4 __attribute__((ext_vector_type(4)));
#define LDS_WAIT() asm volatile("s_waitcnt lgkmcnt(0)" ::: "memory")
#define VM_WAIT() asm volatile("s_waitcnt vmcnt(0)" ::: "memory")
__device__ __forceinline__ float bf_lo(unsigned w) { return __uint_as_float(w << 16); }
__device__ __forceinline__ float bf_hi(unsigned w) { return __uint_as_float(w & 0xffff0000u); }
__device__ __forceinline__ float bf1(bf16 b) { return __uint_as_float(((unsigned)b) << 16); }
__device__ __forceinline__ unsigned pk2(float lo, float hi) { return pg8::cvt_pk_bf16(lo, hi); }
__device__ __forceinline__ bf16 f2bf1(float f) { return (bf16)(pg8::cvt_pk_bf16(f, 0.f) & 0xffffu); }
__device__ __forceinline__ void unpack8(const v4u w, float (&f)[8]) { f[0] = bf_lo(w.x); f[1] = bf_hi(w.x); f[2] = bf_lo(w.y); f[3] = bf_hi(w.y); f[4] = bf_lo(w.z); f[5] = bf_hi(w.z); f[6] = bf_lo(w.w); f[7] = bf_hi(w.w); }
__device__ __forceinline__ v4u pack8(const float (&f)[8]) { v4u w; w.x = pk2(f[0], f[1]); w.y = pk2(f[2], f[3]); w.z = pk2(f[4], f[5]); w.w = pk2(f[6], f[7]); return w; }
__device__ __forceinline__ float sigmoidf_(float x) { return __builtin_amdgcn_rcpf(1.f + __expf(-x)); }
__device__ __forceinline__ float wave_sum(float v) {
#pragma unroll
    for (int o = 1; o < 64; o <<= 1) v += __shfl_xor(v, o);
    return v;
}
__device__ __forceinline__ float wave_max(float v) {
#pragma unroll
    for (int o = 1; o < 64; o <<= 1) v = fmaxf(v, __shfl_xor(v, o));
    return v;
}

#define XB_TMO      128
#define XB_XCNT(j)  (256  + 64 * (j))
#define XB_XSUB(j)  (1280 + 64 * (j))
#define XB_XGEN(j)  (2304 + 64 * (j))
#define XB_TOP      3328
#define XB_TOPGEN   3392
#define XCD_BAR_WORDS 3456
#define XB_SPIN_CAP (1u << 22)
__device__ __forceinline__ unsigned xb_ld(unsigned* p)              { return __hip_atomic_load(p, __ATOMIC_RELAXED, __HIP_MEMORY_SCOPE_AGENT); }
__device__ __forceinline__ unsigned xb_add(unsigned* p, unsigned v) { return __hip_atomic_fetch_add(p, v, __ATOMIC_RELAXED, __HIP_MEMORY_SCOPE_AGENT); }
__device__ __forceinline__ unsigned xb_xcc_id() { return (unsigned)__builtin_amdgcn_s_getreg((3 << 11) | 20) & 0xFu; }
#define XB_SPIN(cond, bar) do { unsigned _sp = 0; while (cond) { __builtin_amdgcn_s_sleep(1); \
    if ((++_sp & 255u) == 0u) { if (xb_ld(&(bar)[XB_TMO])) break; if (_sp > XB_SPIN_CAP) { atomicAdd(&(bar)[XB_TMO], 1u); break; } } } } while (0)
struct XcdBarrier { unsigned* bar; unsigned x; volatile LAS unsigned* st; };
__device__ __forceinline__ XcdBarrier xcd_barrier_post(unsigned* bar, volatile LAS unsigned* st) {
    XcdBarrier b; b.bar = bar; b.x = xb_xcc_id(); b.st = st;
    if (threadIdx.x == 0) (void)xb_add(&bar[XB_XCNT(b.x)], 1u);
    return b;
}
__device__ __forceinline__ void xcd_barrier_complete(unsigned* bar, unsigned x, unsigned& nloc, unsigned& nx) {
    const unsigned G = gridDim.x * gridDim.y * gridDim.z;
    unsigned sum, cnt, mine, sp = 0u;
    for (;;) {
        sum = 0u; cnt = 0u; mine = 0u;
#pragma unroll
        for (unsigned j = 0; j < 16; ++j) { const unsigned c = xb_ld(&bar[XB_XCNT(j)]); sum += c; cnt += (c > 0u) ? 1u : 0u; mine = (j == x) ? c : mine; }
        if (sum == G) break;
        __builtin_amdgcn_s_sleep(1);
        if ((++sp & 255u) == 0u) { if (xb_ld(&bar[XB_TMO])) break; if (sp > XB_SPIN_CAP) { atomicAdd(&bar[XB_TMO], 1u); break; } }
    }
    nloc = mine > 0u ? mine : 1u; nx = cnt > 0u ? cnt : 1u;
}
__device__ __forceinline__ void xcd_barrier(const XcdBarrier& b) {
    asm volatile("s_waitcnt vmcnt(0)" ::: "memory");
    __syncthreads();
    if (threadIdx.x == 0) {
        unsigned* bar = b.bar;
        __builtin_amdgcn_s_waitcnt(0);
        unsigned nloc = b.st[0], nx = b.st[1];
        if (nloc == 0u) { xcd_barrier_complete(bar, b.x, nloc, nx); b.st[0] = nloc; b.st[1] = nx; }
        const unsigned old = xb_add(&bar[XB_XSUB(b.x)], 1u);
        const unsigned gen = old / nloc;
        if (old + 1u == (gen + 1u) * nloc) {
            __builtin_amdgcn_fence(__ATOMIC_RELEASE, "agent");
            asm volatile("s_waitcnt vmcnt(0)" ::: "memory");
            const unsigned og = xb_add(&bar[XB_TOP], 1u);
            const unsigned tg = og / nx;
            if (og + 1u == (tg + 1u) * nx) xb_add(&bar[XB_TOPGEN], 1u);
            else XB_SPIN(xb_ld(&bar[XB_TOPGEN]) == tg, bar);
            __builtin_amdgcn_fence(__ATOMIC_ACQUIRE, "agent");
            xb_add(&bar[XB_XGEN(b.x)], 1u);
            asm volatile("s_waitcnt vmcnt(0)" ::: "memory");
        } else {
            XB_SPIN(xb_ld(&bar[XB_XGEN(b.x)]) == gen, bar);
            __builtin_amdgcn_fence(__ATOMIC_ACQUIRE, "agent");
            asm volatile("s_waitcnt vmcnt(0)" ::: "memory");
        }
    }
    __syncthreads();
}

struct Frame {
    LAS unsigned char* lds;
    int wave, vcu, G;
    const float* in[25];
    float* out; unsigned char* ws;
};
enum InIdx { I_XP = 0, I_XS, I_SGLA, I_CCONV, I_CMK, I_CMV, I_MEMP, I_GMIX, I_WIN, I_WA2, I_BA, I_GGLA, I_WGLAO, I_WCONV, I_WCONVO, I_WXAO, I_GMEM, I_WMEMKV, I_BMERGE, I_WOUT, I_GFFN, I_WFG, I_WFU, I_WFD, I_GFINAL };

__device__ __forceinline__ const float* xrow_ptr(const Frame& F, int row) { return row < TP ? F.in[I_XP] + (size_t)row * DM : F.in[I_XS] + (size_t)(row - TP) * DM; }
__device__ __forceinline__ void chunk_seq(int ci, int& seq, int& cis) { if (ci < NCHK_P) { seq = ci >> 7; cis = ci & 127; } else { seq = 2 + (ci - NCHK_P); cis = 0; } }
__device__ __forceinline__ bf16* slot_ptr(const Frame& F, int ci, int h) {
    if (ci < 128) return (bf16*)(F.ws + WS_DS0) + ((size_t)(ci * NH + h) << 17);
    if (ci < 256) return (bf16*)(F.ws + WS_DS1) + ((size_t)((ci - 128) * NH + h) << 17);
    return (bf16*)(F.ws + WS_DSS) + ((size_t)((ci - 256) * NH + h) << 17);
}

__device__ __forceinline__ void tr_item(const float* Wp, size_t ldw, int nvalid, float scale, bf16* WTp, size_t ldt, LAS float* scr, int lane) {
    const int n = lane & 31;
#pragma unroll 8
    for (int i = 0; i < 32; ++i) { const int kk = 2 * i + (lane >> 5); scr[kk * 33 + n] = (n < nvalid) ? Wp[(size_t)kk * ldw + n] * scale : 0.f; }
    LDS_WAIT(); asm volatile("" ::: "memory");
    const int c = lane & 7;
#pragma unroll
    for (int j = 0; j < 4; ++j) { const int nn = (lane >> 3) + 8 * j; const LAS float* s = scr + (8 * c) * 33 + nn;
        v4u o; o.x = pk2(s[0 * 33], s[1 * 33]); o.y = pk2(s[2 * 33], s[3 * 33]); o.z = pk2(s[4 * 33], s[5 * 33]); o.w = pk2(s[6 * 33], s[7 * 33]);
        *(v4u*)(WTp + (size_t)nn * ldt + 8 * c) = o; }
    LDS_WAIT(); asm volatile("" ::: "memory");
}
__device__ __forceinline__ void rms_row_to_bf16(const float* xrow, const float* g, bf16* orow, int lane) {
    const f32x4* xr = (const f32x4*)xrow + lane; const f32x4* gr = (const f32x4*)g + lane;
    f32x4 v[16]; float s = 0.f;
#pragma unroll
    for (int j = 0; j < 16; ++j) { v[j] = xr[64 * j]; s += (v[j].x * v[j].x + v[j].y * v[j].y) + (v[j].z * v[j].z + v[j].w * v[j].w); }
    const float rstd = rsqrtf(wave_sum(s) * (1.f / DM) + EPS);
    v2u* o8 = (v2u*)orow + lane;
#pragma unroll
    for (int j = 0; j < 16; ++j) { const f32x4 gg = gr[64 * j]; v2u w; w.x = pk2(v[j].x * rstd * gg.x, v[j].y * rstd * gg.y); w.y = pk2(v[j].z * rstd * gg.z, v[j].w * rstd * gg.w); o8[64 * j] = w; }
}

namespace pg8 {
struct EpiZ {
    static constexpr bool PERM = true, KHOOK = false;
    bf16_t* zs; float* alr; bf16_t* gates; const float* bmerge; bf16_t* vT; float* outk; float* outv; bf16_t* mkv; bf16_t* mvT;
    __device__ __forceinline__ void operator()(const f32x4 (&acc)[2][2][4][2], const Unit& u, int wr, int wc, int fr, int fq) const {
        const int row0 = u.pm * BM + wr * 64 + fr;
        if (u.prob == 1) {
            const int col0 = u.pn * BM + wc * 32 + 8 * fq;
#pragma unroll
            for (int ai = 0; ai < 2; ++ai)
#pragma unroll
                for (int m = 0; m < 4; ++m) { bf16_t* rowp = vT + (size_t)(row0 + ai * HALF + m * 16) * T + col0;
#pragma unroll
                    for (int bj = 0; bj < 2; ++bj) { const f32x4 v0 = acc[ai][bj][m][0], v1 = acc[ai][bj][m][1];
                        u32x4 w; w.x = cvt_pk_bf16(v0[0], v0[1]); w.y = cvt_pk_bf16(v0[2], v0[3]); w.z = cvt_pk_bf16(v1[0], v1[1]); w.w = cvt_pk_bf16(v1[2], v1[3]);
                        *(u32x4*)(rowp + bj * HALF) = w; } }
        } else if (u.prob == 3) {
            const int col0 = wc * 32 + 8 * fq; bf16_t* tb = mvT + (size_t)(u.pn * NH + u.pm) * 65536;
#pragma unroll
            for (int ai = 0; ai < 2; ++ai)
#pragma unroll
                for (int m = 0; m < 4; ++m) { bf16_t* rowp = tb + (size_t)(wr * 64 + fr + ai * HALF + m * 16) * 256 + col0;
#pragma unroll
                    for (int bj = 0; bj < 2; ++bj) { const f32x4 v0 = acc[ai][bj][m][0], v1 = acc[ai][bj][m][1];
                        u32x4 w; w.x = cvt_pk_bf16(v0[0], v0[1]); w.y = cvt_pk_bf16(v0[2], v0[3]); w.z = cvt_pk_bf16(v1[0], v1[1]); w.w = cvt_pk_bf16(v1[2], v1[3]);
                        *(u32x4*)(rowp + bj * HALF) = w; } }
        } else if (u.prob == 2) {
            const int col0 = u.pn * BM + wc * 32 + 8 * fq;
            float* ob = col0 < 1024 ? outk + col0 : outv + (col0 - 1024);
#pragma unroll
            for (int ai = 0; ai < 2; ++ai)
#pragma unroll
                for (int m = 0; m < 4; ++m) { const int row = row0 + ai * HALF + m * 16;
#pragma unroll
                    for (int bj = 0; bj < 2; ++bj) { const f32x4 v0 = acc[ai][bj][m][0], v1 = acc[ai][bj][m][1];
                        float* op = ob + (size_t)row * 1024 + bj * HALF; *(f32x4*)op = v0; *(f32x4*)(op + 4) = v1;
                        u32x4 w; w.x = cvt_pk_bf16(v0[0], v0[1]); w.y = cvt_pk_bf16(v0[2], v0[3]); w.z = cvt_pk_bf16(v1[0], v1[1]); w.w = cvt_pk_bf16(v1[2], v1[3]);
                        *(u32x4*)(mkv + (size_t)row * 2048 + col0 + bj * HALF) = w; } }
        } else if (u.pn < 40) {
            const int col0 = u.pn * BM + wc * 32 + 8 * fq;
#pragma unroll
            for (int ai = 0; ai < 2; ++ai)
#pragma unroll
                for (int m = 0; m < 4; ++m) { bf16_t* rowp = zs + (size_t)(row0 + ai * HALF + m * 16) * ZS_LD + col0;
#pragma unroll
                    for (int bj = 0; bj < 2; ++bj) { const f32x4 v0 = acc[ai][bj][m][0], v1 = acc[ai][bj][m][1];
                        u32x4 w; w.x = cvt_pk_bf16(v0[0], v0[1]); w.y = cvt_pk_bf16(v0[2], v0[3]); w.z = cvt_pk_bf16(v1[0], v1[1]); w.w = cvt_pk_bf16(v1[2], v1[3]);
                        *(u32x4*)(rowp + bj * HALF) = w; } }
        } else if (u.pn == 40) {
            if (wc == 0 && fq < 2) {
#pragma unroll
                for (int ai = 0; ai < 2; ++ai)
#pragma unroll
                    for (int m = 0; m < 4; ++m) { float* rp = alr + (size_t)(row0 + ai * HALF + m * 16) * RANK + 8 * fq;
                        *(f32x4*)rp = acc[ai][0][m][0]; *(f32x4*)(rp + 4) = acc[ai][0][m][1]; }
            }
        } else {
            const int col0 = (u.pn - 41) * BM + wc * 32 + 8 * fq;
            f32x4 bv[2][2];
#pragma unroll
            for (int bj = 0; bj < 2; ++bj)
#pragma unroll
                for (int n = 0; n < 2; ++n) bv[bj][n] = *(const f32x4*)(bmerge + col0 + bj * HALF + 4 * n);
#pragma unroll
            for (int ai = 0; ai < 2; ++ai)
#pragma unroll
                for (int m = 0; m < 4; ++m) { bf16_t* rowp = gates + (size_t)(row0 + ai * HALF + m * 16) * G_LD + col0;
#pragma unroll
                    for (int bj = 0; bj < 2; ++bj) { f32x4 v0 = acc[ai][bj][m][0] + bv[bj][0], v1 = acc[ai][bj][m][1] + bv[bj][1];
#pragma unroll
                        for (int j = 0; j < 4; ++j) { v0[j] = sigmoidf_(v0[j]); v1[j] = sigmoidf_(v1[j]); }
                        u32x4 w; w.x = cvt_pk_bf16(v0[0], v0[1]); w.y = cvt_pk_bf16(v0[2], v0[3]); w.z = cvt_pk_bf16(v1[0], v1[1]); w.w = cvt_pk_bf16(v1[2], v1[3]);
                        *(u32x4*)(rowp + bj * HALF) = w; } }
        }
    }
};
struct EpiMix {
    static constexpr bool PERM = true, KHOOK = true;
    const bf16_t* gates; bf16_t* mixed;
    __device__ __forceinline__ void khook(f32x4 (&acc)[2][2][4][2], const Unit& u, int seg, int wr, int wc, int fr, int fq) const {
        const unsigned char* gb0 = (const unsigned char*)gates + ((size_t)(u.pm * BM + wr * 64) * G_LD + seg * DM + u.pn * BM + wc * 32) * 2;
        const unsigned lo = (unsigned)(fr * G_LD + 8 * fq) * 2u;
#pragma unroll
        for (int ai = 0; ai < 2; ++ai)
#pragma unroll
            for (int m = 0; m < 4; ++m) {
                u32x4 ga[2], gb[2];
#pragma unroll
                for (int bj = 0; bj < 2; ++bj) { const unsigned char* p = gb0 + (size_t)((ai * HALF + m * 16) * G_LD + bj * HALF) * 2; ga[bj] = *(const u32x4*)(p + lo); gb[bj] = *(const u32x4*)(p + DM * 2 + lo); }
#pragma unroll
                for (int bj = 0; bj < 2; ++bj) { float a[8], b[8]; unpack8(ga[bj], a); unpack8(gb[bj], b);
#pragma unroll
                    for (int j = 0; j < 4; ++j) { acc[ai][bj][m][0][j] *= a[j] * __builtin_amdgcn_rcpf(fmaxf(b[j], 1e-30f)); acc[ai][bj][m][1][j] *= a[4 + j] * __builtin_amdgcn_rcpf(fmaxf(b[4 + j], 1e-30f)); } }
                __builtin_amdgcn_sched_barrier(0);
            }
    }
    __device__ __forceinline__ void operator()(const f32x4 (&acc)[2][2][4][2], const Unit& u, int wr, int wc, int fr, int fq) const {
        const int row0 = u.pm * BM + wr * 64 + fr, col0 = u.pn * BM + wc * 32 + 8 * fq;
#pragma unroll
        for (int ai = 0; ai < 2; ++ai)
#pragma unroll
            for (int m = 0; m < 4; ++m) { const size_t row = (size_t)(row0 + ai * HALF + m * 16);
#pragma unroll
                for (int bj = 0; bj < 2; ++bj) { float g[8]; unpack8(*(const u32x4*)(gates + row * G_LD + 2 * DM + col0 + bj * HALF), g);
                    const f32x4 v0 = acc[ai][bj][m][0], v1 = acc[ai][bj][m][1];
                    u32x4 w; w.x = cvt_pk_bf16(v0[0] * g[0], v0[1] * g[1]); w.y = cvt_pk_bf16(v0[2] * g[2], v0[3] * g[3]); w.z = cvt_pk_bf16(v1[0] * g[4], v1[1] * g[5]); w.w = cvt_pk_bf16(v1[2] * g[6], v1[3] * g[7]);
                    *(u32x4*)(mixed + row * DM + col0 + bj * HALF) = w; } }
    }
};
struct EpiX1 {
    static constexpr bool PERM = false, KHOOK = false;
    const float* xp; const float* xs; float* out;
    __device__ __forceinline__ void operator()(const f32x4 (&acc)[2][2][4][2], const Unit& u, int wr, int wc, int fr, int fq) const {
        const int row0 = u.pm * BM + wr * 64 + fr, col0 = u.pn * BM + wc * 32 + 4 * fq;
#pragma unroll
        for (int ai = 0; ai < 2; ++ai)
#pragma unroll
            for (int m = 0; m < 4; ++m) { const int row = row0 + ai * HALF + m * 16; const float* xr = (row < TP ? xp + (size_t)row * DM : xs + (size_t)(row - TP) * DM) + col0; float* orow = out + (size_t)row * DM + col0;
#pragma unroll
                for (int bj = 0; bj < 2; ++bj)
#pragma unroll
                    for (int n = 0; n < 2; ++n) *(f32x4*)(orow + bj * HALF + n * 16) = *(const f32x4*)(xr + bj * HALF + n * 16) + acc[ai][bj][m][n]; }
    }
};
struct EpiGU {
    static constexpr bool PERM = true, KHOOK = false;
    bf16_t* h;
    __device__ __forceinline__ void operator()(const f32x4 (&acc)[2][2][4][2], const Unit& u, int wr, int wc, int fr, int fq) const {
        const int row0 = u.pm * BM + wr * 64 + fr, col0 = u.pn * HALF + wc * 32 + 8 * fq;
#pragma unroll
        for (int ai = 0; ai < 2; ++ai)
#pragma unroll
            for (int m = 0; m < 4; ++m) { float o[8];
#pragma unroll
                for (int n = 0; n < 2; ++n)
#pragma unroll
                    for (int j = 0; j < 4; ++j) { const float gt = acc[ai][0][m][n][j], up = acc[ai][1][m][n][j]; o[4 * n + j] = gt * sigmoidf_(gt) * up; }
                u32x4 w; w.x = cvt_pk_bf16(o[0], o[1]); w.y = cvt_pk_bf16(o[2], o[3]); w.z = cvt_pk_bf16(o[4], o[5]); w.w = cvt_pk_bf16(o[6], o[7]);
                *(u32x4*)(h + (size_t)(row0 + ai * HALF + m * 16) * DFF + col0) = w; }
    }
};
struct EpiDown {
    static constexpr bool PERM = false, KHOOK = false;
    float* out;
    __device__ __forceinline__ void operator()(const f32x4 (&acc)[2][2][4][2], const Unit& u, int wr, int wc, int fr, int fq) const {
        const int row0 = u.pm * BM + wr * 64 + fr, col0 = u.pn * BM + wc * 32 + 4 * fq;
#pragma unroll
        for (int ai = 0; ai < 2; ++ai)
#pragma unroll
            for (int m = 0; m < 4; ++m) { float* orow = out + (size_t)(row0 + ai * HALF + m * 16) * DM + col0;
#pragma unroll
                for (int bj = 0; bj < 2; ++bj)
#pragma unroll
                    for (int n = 0; n < 2; ++n) { f32x4* p = (f32x4*)(orow + bj * HALF + n * 16); *p = *p + acc[ai][bj][m][n]; } }
    }
};
}

__device__ __forceinline__ v4u ldg16(const unsigned char* ubase, unsigned off) { return *(const v4u*)(ubase + off); }
__device__ __forceinline__ void stg16(unsigned char* ubase, unsigned off, v4u v) { *(v4u*)(ubase + off) = v; }
__device__ __forceinline__ void win_map(int drow, int& src, int& nvalid, float& scale) {
    nvalid = 32; scale = 1.f;
    if (drow < 4096) { src = drow; if (drow < 1024) scale = 0.0625f; }
    else if (drow < 10240) { src = drow + 16; if (drow >= ZXQ) scale = 0.0625f; }
    else if (drow == 10240) { src = 4096; nvalid = 16; }
    else if (drow < 10496) { src = 0; nvalid = 0; }
    else src = drow - 240;
}
__device__ __forceinline__ void ph0_prologue(Frame& F) {
    int tid_ = threadIdx.x; asm volatile("" : "+v"(tid_)); const int tid = tid_, lane = tid & 63; (void)lane;
    LAS float* scr = (LAS float*)(F.lds + F.wave * 16384);
    const int gw = F.vcu * NWAVES + F.wave, NGW = F.G * NWAVES;
    bf16* Wint = (bf16*)(F.ws + WS_RA); bf16* Wbr = (bf16*)(F.ws + WS_WBR); bf16* Wout = (bf16*)(F.ws + WS_WOUT); bf16* Wkv = (bf16*)(F.ws + WS_WKV);
    constexpr int I_IN = (NIN_T / 32) * 64, I_GLA = 128 * 32, I_CV = 128 * 16, I_XA = 128 * 16, I_OUT = 128 * 64, I_KV = 64 * 64;
    constexpr int NITEMS = I_IN + I_GLA + I_CV + I_XA + I_OUT + I_KV;
    for (int it = gw; it < NITEMS; it += NGW) {
        int r = it;
        if (r < I_IN) { const int nb = r >> 6, kb = r & 63; int src, nv; float sc; win_map(nb * 32, src, nv, sc);
            tr_item(F.in[I_WIN] + (size_t)(kb * 64) * IN_COLS + src, IN_COLS, nv, sc, Wint + (size_t)(nb * 32) * DM + kb * 64, DM, scr, lane); continue; } r -= I_IN;
        if (r < I_GLA) { const int nb = r >> 5, kb = r & 31;
            tr_item(F.in[I_WGLAO] + (size_t)(kb * 64) * DM + nb * 32, DM, 32, 1.f, Wbr + (size_t)(nb * 32) * DM + kb * 64, DM, scr, lane); continue; } r -= I_GLA;
        if (r < I_CV) { const int nb = r >> 4, kb = r & 15;
            tr_item(F.in[I_WCONVO] + (size_t)(kb * 64) * DM + nb * 32, DM, 32, 1.f, Wbr + (size_t)(nb * 32) * DM + 2048 + kb * 64, DM, scr, lane); continue; } r -= I_CV;
        if (r < I_XA) { const int nb = r >> 4, kb = r & 15;
            tr_item(F.in[I_WXAO] + (size_t)(kb * 64) * DM + nb * 32, DM, 32, 1.f, Wbr + (size_t)(nb * 32) * DM + 3072 + kb * 64, DM, scr, lane); continue; } r -= I_XA;
        if (r < I_OUT) { const int nb = r >> 6, kb = r & 63;
            tr_item(F.in[I_WOUT] + (size_t)(kb * 64) * DM + nb * 32, DM, 32, 1.f, Wout + (size_t)(nb * 32) * DM + kb * 64, DM, scr, lane); continue; } r -= I_OUT;
        { const int nb = r >> 6, kb = r & 63;
            tr_item(F.in[I_WMEMKV] + (size_t)(kb * 64) * 2048 + nb * 32, 2048, 32, 1.f, Wkv + (size_t)(nb * 32) * DM + kb * 64, DM, scr, lane); }
    }
    bf16* xn = (bf16*)((unsigned char*)F.out + OY_XN); bf16* memn = (bf16*)(F.ws + WS_MEMN);
    for (int m = gw; m < T + 512; m += NGW) {
        if (m < T) rms_row_to_bf16(xrow_ptr(F, m), F.in[I_GMIX], xn + (size_t)m * DM, lane);
        else rms_row_to_bf16(F.in[I_MEMP] + (size_t)(m - T) * DM, F.in[I_GMEM], memn + (size_t)(m - T) * DM, lane);
    }
    bf16* mkv = (bf16*)(F.ws + WS_MKV);
    const int gt = F.vcu * NTHR + tid, NGT = F.G * NTHR;
    for (int i = gt; i < 32 * 256 * 256; i += NGT) {
        const int row = i >> 8, c4 = i & 255;
        const f32x4 v = *((const f32x4*)(F.in[I_CMK]) + (size_t)row * 256 + c4);
        v2u w; w.x = pk2(v.x, v.y); w.y = pk2(v.z, v.w);
        *(v2u*)(mkv + (size_t)(512 + row) * 2048 + c4 * 4) = w;
    }
    bf16* mvT = (bf16*)(F.ws + WS_MVT);
    for (int it = gw; it < 32 * 128; it += NGW) { const int b = it >> 7, nb = (it >> 2) & 31, kb = it & 3;
        tr_item(F.in[I_CMV] + (size_t)b * 262144 + (size_t)(kb * 64) * 1024 + nb * 32, 1024, 32, 1.f, mvT + (size_t)(2 + b) * 262144 + (size_t)(nb * 32) * 256 + kb * 64, 256, scr, lane); }
}

__device__ __forceinline__ void ph_g0(Frame& F) {
    int tid_ = threadIdx.x; asm volatile("" : "+v"(tid_)); const int tid = tid_, lane = tid & 63; (void)lane;
    bf16* zs = (bf16*)(F.ws + WS_ZS); const float* alr = (const float*)(F.ws + WS_ALR); float* Aout = (float*)(F.ws + WS_AOUT); bf16* kinT = (bf16*)(F.ws + WS_KINT);
    LAS float* alr_s = (LAS float*)F.lds; LAS float* tot = alr_s + 64 * 16;
    const int c = tid & 127, tg = tid >> 7;
    for (int unit = F.vcu; unit < NCHK * 8; unit += F.G) {
        const int ci = unit >> 3, ch = (unit & 7) * 128 + c;
        __syncthreads();
        if (tid < 256) *(LAS f32x4*)(alr_s + tid * 4) = *(const f32x4*)(alr + (size_t)ci * 64 * RANK + tid * 4);
        float w[16];
#pragma unroll
        for (int r = 0; r < 16; ++r) w[r] = F.in[I_WA2][r * GK + ch];
        const float ba = F.in[I_BA][ch];
        __syncthreads();
        float Bl[16]; float run = 0.f;
#pragma unroll
        for (int tt = 0; tt < 16; ++tt) { const LAS float* ar = alr_s + (tg * 16 + tt) * 16; float x = ba;
#pragma unroll
            for (int r = 0; r < 16; ++r) x += ar[r] * w[r];
            const float ls = fminf(x, 0.f) - log1pf(__expf(-fabsf(x)));
            run += ls * 0.0625f; Bl[tt] = run; }
        tot[tg * 128 + c] = run;
        __syncthreads();
        float off = 0.f, blast = 0.f;
#pragma unroll
        for (int g = 0; g < 4; ++g) { const float tv = tot[g * 128 + c]; blast += tv; if (g < tg) off += tv; }
        bf16 kt[16];
#pragma unroll
        for (int tt = 0; tt < 16; ++tt) { const float B = Bl[tt] + off; const size_t row = (size_t)ci * 64 + tg * 16 + tt;
            bf16* qp = zs + row * ZS_LD + ZQ + ch; bf16* kp = zs + row * ZS_LD + ZK + ch;
            const bf16 kn = f2bf1(bf1(*kp) * __expf(-B)); kt[tt] = kn;
            *qp = f2bf1(bf1(*qp) * __expf(B)); *kp = kn; }
        { v4u w0, w1; w0.x = kt[0] | ((unsigned)kt[1] << 16); w0.y = kt[2] | ((unsigned)kt[3] << 16); w0.z = kt[4] | ((unsigned)kt[5] << 16); w0.w = kt[6] | ((unsigned)kt[7] << 16);
          w1.x = kt[8] | ((unsigned)kt[9] << 16); w1.y = kt[10] | ((unsigned)kt[11] << 16); w1.z = kt[12] | ((unsigned)kt[13] << 16); w1.w = kt[14] | ((unsigned)kt[15] << 16);
          bf16* ktp = kinT + (size_t)ch * T + ci * 64 + tg * 16; *(v4u*)ktp = w0; *(v4u*)(ktp + 8) = w1; }
        if (tg == 0) Aout[(size_t)ci * GK + ch] = __expf(blast);
    }
}
__device__ __forceinline__ void ph_conv(Frame& F) {
    int tid_ = threadIdx.x; asm volatile("" : "+v"(tid_)); const int tid = tid_, lane = tid & 63; (void)lane;
    const bf16* zs = (const bf16*)(F.ws + WS_ZS); bf16* br = (bf16*)((unsigned char*)F.out + OY_BR);
    const int gt = F.vcu * NTHR + tid, NGT = F.G * NTHR;
    for (int item = gt; item < T * 128; item += NGT) {
        const int row = item >> 7, c8 = (item & 127) * 8;
        int t, Tlen, sb; if (row < TP) { t = row & (SEQP - 1); Tlen = SEQP; sb = -1; } else { t = (row - TP) & 63; Tlen = 64; sb = (row - TP) >> 6; }
        float u[3][8];
#pragma unroll
        for (int d = 0; d < 3; ++d) {
            if (t - d >= 0) { float a[8], b[8]; unpack8(*(const v4u*)(zs + (size_t)(row - d) * ZS_LD + ZCC + c8), a); unpack8(*(const v4u*)(zs + (size_t)(row - d) * ZS_LD + ZCH + c8), b);
#pragma unroll
                for (int j = 0; j < 8; ++j) u[d][j] = a[j] * b[j]; }
            else if (sb >= 0) { const float* bp = F.in[I_CCONV] + ((size_t)sb * 2 + (t - d + 2)) * CW + c8;
#pragma unroll
                for (int j = 0; j < 8; ++j) u[d][j] = bp[j]; }
            else {
#pragma unroll
                for (int j = 0; j < 8; ++j) u[d][j] = 0.f; }
        }
        float cb[8], o[8]; unpack8(*(const v4u*)(zs + (size_t)row * ZS_LD + ZCB + c8), cb);
        const float* wc = F.in[I_WCONV] + c8;
#pragma unroll
        for (int j = 0; j < 8; ++j) o[j] = cb[j] * (u[2][j] * wc[j] + u[1][j] * wc[CW + j] + u[0][j] * wc[2 * CW + j]);
        *(v4u*)(br + (size_t)row * DM + 2048 + c8) = pack8(o);
        if (t >= Tlen - 2) { float* ob = (sb < 0) ? F.out + O_CCP + ((size_t)(row >> 13) * 2 + (t - (Tlen - 2))) * CW + c8 : F.out + O_CCS + ((size_t)sb * 2 + (t - (Tlen - 2))) * CW + c8;
#pragma unroll
            for (int j = 0; j < 8; ++j) ob[j] = u[0][j]; }
    }
}
typedef short bf16x8 __attribute__((ext_vector_type(8)));
__device__ __forceinline__ bf16x8 ldfrag(const unsigned char* ubase, unsigned off) { return *(const bf16x8*)(ubase + off); }
__device__ __forceinline__ void ph_g1(Frame& F) {
    int tid_ = threadIdx.x; asm volatile("" : "+v"(tid_)); const int tid = tid_, lane = tid & 63, fr = lane & 15, fq = lane >> 4, w = F.wave;
    const unsigned lrow = (unsigned)(fr * T + 8 * fq) * 2u;
    for (int unit = F.vcu; unit < NCHK * NH; unit += F.G) {
        const int ci = unit >> 2, h = unit & 3;
        const unsigned char* vb = F.ws + WS_VT + ((size_t)(h * DV + 64 * w) * T + ci * 64) * 2;
        const unsigned char* kb = F.ws + WS_KINT + ((size_t)(h * DK) * T + ci * 64) * 2;
        unsigned char* slot = (unsigned char*)slot_ptr(F, ci, h);
        const float* Ap = (const float*)(F.ws + WS_AOUT) + (size_t)ci * GK + h * DK;
        bf16x8 fv[4][2];
#pragma unroll
        for (int n = 0; n < 4; ++n)
#pragma unroll
            for (int ks = 0; ks < 2; ++ks) fv[n][ks] = ldfrag(vb + (size_t)(16 * n) * T * 2 + ks * 64, lrow);
#pragma unroll 1
        for (int qd = 0; qd < 4; ++qd) {
            bf16x8 fk[4][2]; f32x4 acc[4][4];
#pragma unroll
            for (int c = 0; c < 4; ++c)
#pragma unroll
                for (int ks = 0; ks < 2; ++ks) fk[c][ks] = ldfrag(kb + (size_t)(64 * qd + 16 * c) * T * 2 + ks * 64, lrow);
#pragma unroll
            for (int n = 0; n < 4; ++n)
#pragma unroll
                for (int c = 0; c < 4; ++c) { acc[n][c] = (f32x4){0.f, 0.f, 0.f, 0.f};
#pragma unroll
                    for (int ks = 0; ks < 2; ++ks) acc[n][c] = __builtin_amdgcn_mfma_f32_16x16x32_bf16(fk[c][ks], fv[n][ks], acc[n][c], 0, 0, 0); }
#pragma unroll
            for (int c = 0; c < 4; ++c) { const int dk0 = 64 * qd + 16 * c + 4 * fq; const f32x4 A = *(const f32x4*)(Ap + dk0);
#pragma unroll
                for (int n = 0; n < 4; ++n) { const f32x4 v = acc[n][c] * A; v2u o; o.x = pk2(v[0], v[1]); o.y = pk2(v[2], v[3]);
                    *(v2u*)(slot + ((size_t)(64 * w + 16 * n + fr) * DK + dk0) * 2) = o; } }
        }
    }
}
__device__ __forceinline__ void ph_xattn(Frame& F) {
    int tid_ = threadIdx.x; asm volatile("" : "+v"(tid_)); const int tid = tid_, lane = tid & 63, fr = lane & 15, fq = lane >> 4, w = F.wave;
    const unsigned zrow = (unsigned)(fr * ZS_LD + 8 * fq) * 2u, krow = (unsigned)(fr * 2048 + 8 * fq) * 2u, vrow = (unsigned)(fr * 256 + 4 * fq) * 2u;
    for (int pu = F.vcu; pu < NCHK * NH / 2; pu += F.G) {
        const int unit = 2 * pu + (w >> 2), ci = unit >> 2, h = unit & 3; int seq, cis; chunk_seq(ci, seq, cis);
        const int t0 = ci * 64 + 16 * (w & 3);
        const unsigned char* qb = F.ws + WS_ZS + ((size_t)t0 * ZS_LD + ZXQ + h * XDH) * 2;
        const unsigned char* kb = F.ws + WS_MKV + ((size_t)seq * 256 * 2048 + h * XDH) * 2;
        const unsigned char* vb = F.ws + WS_MVT + (size_t)(seq * NH + h) * 65536 * 2;
        bf16x8 fqx[8];
#pragma unroll
        for (int ks = 0; ks < 8; ++ks) fqx[ks] = ldfrag(qb + ks * 64, zrow);
        f32x4 sc[16];
#pragma unroll
        for (int c = 0; c < 16; ++c) { sc[c] = (f32x4){0.f, 0.f, 0.f, 0.f};
            bf16x8 fk[8];
#pragma unroll
            for (int ks = 0; ks < 8; ++ks) fk[ks] = ldfrag(kb + (size_t)(16 * c) * 4096 + ks * 64, krow);
#pragma unroll
            for (int ks = 0; ks < 8; ++ks) sc[c] = __builtin_amdgcn_mfma_f32_16x16x32_bf16(fk[ks], fqx[ks], sc[c], 0, 0, 0); }
        float mx = -3.0e38f;
#pragma unroll
        for (int c = 0; c < 16; ++c) mx = fmaxf(mx, fmaxf(fmaxf(sc[c][0], sc[c][1]), fmaxf(sc[c][2], sc[c][3])));
        mx = fmaxf(mx, __shfl_xor(mx, 16)); mx = fmaxf(mx, __shfl_xor(mx, 32));
        float sm = 0.f;
#pragma unroll
        for (int c = 0; c < 16; ++c)
#pragma unroll
            for (int i = 0; i < 4; ++i) { const float e = __expf(sc[c][i] - mx); sc[c][i] = e; sm += e; }
        sm += __shfl_xor(sm, 16); sm += __shfl_xor(sm, 32);
        const float inv = 1.f / sm;
        bf16x8 pb[8];
#pragma unroll
        for (int k2 = 0; k2 < 8; ++k2) { v4u u; u.x = pk2(sc[2 * k2][0] * inv, sc[2 * k2][1] * inv); u.y = pk2(sc[2 * k2][2] * inv, sc[2 * k2][3] * inv);
            u.z = pk2(sc[2 * k2 + 1][0] * inv, sc[2 * k2 + 1][1] * inv); u.w = pk2(sc[2 * k2 + 1][2] * inv, sc[2 * k2 + 1][3] * inv); pb[k2] = __builtin_bit_cast(bf16x8, u); }
        unsigned char* ob = (unsigned char*)F.out + OY_BR + ((size_t)(t0 + fr) * DM + 3072 + h * XDH + 4 * fq) * 2;
#pragma unroll 4
        for (int c = 0; c < 16; ++c) {
            f32x4 oc = (f32x4){0.f, 0.f, 0.f, 0.f};
            v2u va[8], vc[8];
#pragma unroll
            for (int k2 = 0; k2 < 8; ++k2) { const unsigned char* pp = vb + (size_t)(16 * c) * 512 + k2 * 64; va[k2] = *(const v2u*)(pp + vrow); vc[k2] = *(const v2u*)(pp + 32 + vrow); }
#pragma unroll
            for (int k2 = 0; k2 < 8; ++k2) { v4u u; u.x = va[k2].x; u.y = va[k2].y; u.z = vc[k2].x; u.w = vc[k2].y;
                oc = __builtin_amdgcn_mfma_f32_16x16x32_bf16(__builtin_bit_cast(bf16x8, u), pb[k2], oc, 0, 0, 0); }
            v2u ow; ow.x = pk2(oc[0], oc[1]); ow.y = pk2(oc[2], oc[3]); *(v2u*)(ob + c * 32) = ow;
        }
    }
}
__device__ __forceinline__ void ph_g2(Frame& F) {
    int tid_ = threadIdx.x; asm volatile("" : "+v"(tid_)); const int tid = tid_;
    const float* Aout = (const float*)(F.ws + WS_AOUT);
    const int gt = F.vcu * NTHR + tid, NGT = F.G * NTHR;
    for (int item = gt; item < 2 * NH * DV * 32; item += NGT) {
        const int dk8 = item & 31, dv = (item >> 5) & 511, h = (item >> 14) & 3, seq = item >> 16;
        float S[8];
#pragma unroll
        for (int e = 0; e < 8; ++e) S[e] = 0.f;
#pragma unroll 4
        for (int c = 0; c < 128; ++c) { const int ci = seq * 128 + c;
            v4u* sp = (v4u*)(slot_ptr(F, ci, h) + (size_t)dv * DK + dk8 * 8); float d[8]; unpack8(*sp, d); *sp = pack8(S);
            const float* ap = Aout + (size_t)ci * GK + h * DK + dk8 * 8; const f32x4 a0 = *(const f32x4*)ap, a1 = *(const f32x4*)(ap + 4);
            S[0] = a0.x * S[0] + d[0]; S[1] = a0.y * S[1] + d[1]; S[2] = a0.z * S[2] + d[2]; S[3] = a0.w * S[3] + d[3];
            S[4] = a1.x * S[4] + d[4]; S[5] = a1.y * S[5] + d[5]; S[6] = a1.z * S[6] + d[6]; S[7] = a1.w * S[7] + d[7]; }
        float* op = F.out + O_SGP + ((size_t)((seq * NH + h) * DK + dk8 * 8)) * DV + dv;
#pragma unroll
        for (int e = 0; e < 8; ++e) op[(size_t)e * DV] = S[e];
    }
    LAS float* t_s = (LAS float*)F.lds;
    for (int unit = F.vcu; unit < 32 * NH * 8; unit += F.G) {
        const int vb = unit & 7, h = (unit >> 3) & 3, b = unit >> 5; const int ci = NCHK_P + b;
        const size_t so = ((size_t)((b * NH + h) * DK)) * DV + vb * 64;
        const float* s0p = F.in[I_SGLA] + so; float* outp = F.out + O_SGS + so;
        bf16* slot = slot_ptr(F, ci, h) + (size_t)(vb * 64) * DK;
        const float* ap = Aout + (size_t)ci * GK + h * DK;
        __syncthreads();
#pragma unroll
        for (int q = 0; q < 8; ++q) { const int idx = tid + q * NTHR, dk = idx >> 4, d4 = (idx & 15) * 4;
            const f32x4 v = *(const f32x4*)(s0p + (size_t)dk * DV + d4);
            t_s[dk * 65 + d4] = v.x; t_s[dk * 65 + d4 + 1] = v.y; t_s[dk * 65 + d4 + 2] = v.z; t_s[dk * 65 + d4 + 3] = v.w; }
        __syncthreads();
#pragma unroll
        for (int q = 0; q < 4; ++q) { const int idx = tid + q * NTHR, dv = idx >> 5, dk8 = idx & 31;
            v4u* sp = (v4u*)(slot + (size_t)dv * DK + dk8 * 8); float d[8], s[8]; unpack8(*sp, d);
#pragma unroll
            for (int e = 0; e < 8; ++e) s[e] = t_s[(dk8 * 8 + e) * 65 + dv];
            *sp = pack8(s);
            const f32x4 a0 = *(const f32x4*)(ap + dk8 * 8), a1 = *(const f32x4*)(ap + dk8 * 8 + 4); const float a[8] = {a0.x, a0.y, a0.z, a0.w, a1.x, a1.y, a1.z, a1.w};
#pragma unroll
            for (int e = 0; e < 8; ++e) t_s[(dk8 * 8 + e) * 65 + dv] = a[e] * s[e] + d[e]; }
        __syncthreads();
#pragma unroll
        for (int q = 0; q < 8; ++q) { const int idx = tid + q * NTHR, dk = idx >> 4, d4 = (idx & 15) * 4;
            *(f32x4*)(outp + (size_t)dk * DV + d4) = (f32x4){t_s[dk * 65 + d4], t_s[dk * 65 + d4 + 1], t_s[dk * 65 + d4 + 2], t_s[dk * 65 + d4 + 3]}; }
    }
}
__device__ __forceinline__ void ph_g3(Frame& F) {
    int tid_ = threadIdx.x; asm volatile("" : "+v"(tid_)); const int tid = tid_, lane = tid & 63, fr = lane & 15, fq = lane >> 4, w = F.wave;
    constexpr int PP = 144;
    LAS unsigned char* P_s = F.lds; LAS float* red = (LAS float*)(F.lds + 64 * PP);
    const unsigned zrow = (unsigned)(fr * ZS_LD + 8 * fq) * 2u;
    const unsigned srow = (unsigned)(fr * DK + 8 * fq) * 2u;
    const unsigned vrow = (unsigned)(fr * T + 8 * fq) * 2u;
    for (int unit = F.vcu; unit < NCHK * NH; unit += F.G) {
        const int ci = unit >> 2, h = unit & 3;
        const unsigned char* zc = F.ws + WS_ZS + (size_t)ci * 64 * ZS_LD * 2;
        const unsigned char* qb = zc + (ZQ + h * DK) * 2; const unsigned char* kb = zc + (ZK + h * DK) * 2;
        __syncthreads();
        {
            const int a = w >> 1; f32x4 pc[2] = {(f32x4){0.f, 0.f, 0.f, 0.f}, (f32x4){0.f, 0.f, 0.f, 0.f}};
#pragma unroll
            for (int ks = 0; ks < 8; ++ks) { const bf16x8 fqn = ldfrag(qb + (size_t)(16 * a) * ZS_LD * 2 + ks * 64, zrow);
#pragma unroll
                for (int c2 = 0; c2 < 2; ++c2) { const bf16x8 fkn = ldfrag(kb + (size_t)(16 * (2 * (w & 1) + c2)) * ZS_LD * 2 + ks * 64, zrow);
                    pc[c2] = __builtin_amdgcn_mfma_f32_16x16x32_bf16(fkn, fqn, pc[c2], 0, 0, 0); } }
#pragma unroll
            for (int c2 = 0; c2 < 2; ++c2) { const int t = 16 * a + fr, s0 = 16 * (2 * (w & 1) + c2) + 4 * fq; float pv[4];
#pragma unroll
                for (int i = 0; i < 4; ++i) pv[i] = (s0 + i <= t) ? pc[c2][i] : 0.f;
                v2u o; o.x = pk2(pv[0], pv[1]); o.y = pk2(pv[2], pv[3]); *(LAS v2u*)(P_s + t * PP + s0 * 2) = o; }
        }
        __syncthreads();
        f32x4 acc[4][4];
#pragma unroll
        for (int n = 0; n < 4; ++n)
#pragma unroll
            for (int a = 0; a < 4; ++a) acc[n][a] = (f32x4){0.f, 0.f, 0.f, 0.f};
        const unsigned char* sb = (const unsigned char*)slot_ptr(F, ci, h) + (size_t)(64 * w) * DK * 2;
#pragma unroll 2
        for (int ks = 0; ks < 8; ++ks) {
            bf16x8 fs[4], fqn[4];
#pragma unroll
            for (int n = 0; n < 4; ++n) fs[n] = ldfrag(sb + (size_t)(16 * n) * DK * 2 + ks * 64, srow);
#pragma unroll
            for (int a = 0; a < 4; ++a) fqn[a] = ldfrag(qb + (size_t)(16 * a) * ZS_LD * 2 + ks * 64, zrow);
#pragma unroll
            for (int n = 0; n < 4; ++n)
#pragma unroll
                for (int a = 0; a < 4; ++a) acc[n][a] = __builtin_amdgcn_mfma_f32_16x16x32_bf16(fs[n], fqn[a], acc[n][a], 0, 0, 0);
        }
        const unsigned char* vb = F.ws + WS_VT + ((size_t)(h * DV + 64 * w) * T + ci * 64) * 2;
#pragma unroll
        for (int ks = 0; ks < 2; ++ks) {
            bf16x8 fv[4], fp[4];
#pragma unroll
            for (int n = 0; n < 4; ++n) fv[n] = ldfrag(vb + (size_t)(16 * n) * T * 2 + ks * 64, vrow);
#pragma unroll
            for (int a = 0; a < 4; ++a) fp[a] = *(const LAS bf16x8*)(P_s + (16 * a + fr) * PP + ks * 64 + fq * 16);
#pragma unroll
            for (int n = 0; n < 4; ++n)
#pragma unroll
                for (int a = 0; a < 4; ++a) acc[n][a] = __builtin_amdgcn_mfma_f32_16x16x32_bf16(fv[n], fp[a], acc[n][a], 0, 0, 0);
        }
#pragma unroll
        for (int a = 0; a < 4; ++a) { float ss = 0.f;
#pragma unroll
            for (int n = 0; n < 4; ++n) ss += (acc[n][a][0] * acc[n][a][0] + acc[n][a][1] * acc[n][a][1]) + (acc[n][a][2] * acc[n][a][2] + acc[n][a][3] * acc[n][a][3]);
            ss += __shfl_xor(ss, 16); ss += __shfl_xor(ss, 32);
            if (fq == 0) red[(16 * a + fr) * 8 + w] = ss; }
        __syncthreads();
        const unsigned char* rb = zc + (ZR + h * DV + 64 * w) * 2; unsigned char* bb = (unsigned char*)F.out + OY_BR + ((size_t)ci * 64 * DM + h * DV + 64 * w) * 2;
#pragma unroll
        for (int a = 0; a < 4; ++a) { const int t = 16 * a + fr; const LAS f32x4* rp = (const LAS f32x4*)(red + t * 8); const f32x4 r0 = rp[0], r1 = rp[1];
            const float rstd = rsqrtf(((r0.x + r0.y) + (r0.z + r0.w) + (r1.x + r1.y) + (r1.z + r1.w)) * (1.f / DV) + EPS);
#pragma unroll
            for (int n = 0; n < 4; ++n) { const int dvl = 16 * n + 4 * fq; const f32x4 gg = *(const f32x4*)(F.in[I_GGLA] + 64 * w + dvl);
                const v2u rw = *(const v2u*)(rb + (size_t)t * ZS_LD * 2 + dvl * 2); const float rr[4] = {bf_lo(rw.x), bf_hi(rw.x), bf_lo(rw.y), bf_hi(rw.y)}; float o[4];
#pragma unroll
                for (int i = 0; i < 4; ++i) o[i] = acc[n][a][i] * rstd * gg[i] * (rr[i] * sigmoidf_(rr[i]));
                v2u ow; ow.x = pk2(o[0], o[1]); ow.y = pk2(o[2], o[3]); *(v2u*)(bb + (size_t)t * DM * 2 + dvl * 2) = ow; } }
    }
}
__device__ __forceinline__ void ph8_hn_ffnw(Frame& F) {
    int tid_ = threadIdx.x; asm volatile("" : "+v"(tid_)); const int tid = tid_, lane = tid & 63; (void)lane;
    LAS float* scr = (LAS float*)(F.lds + F.wave * 16384);
    const int gw = F.vcu * NWAVES + F.wave, NGW = F.G * NWAVES;
    bf16* Wgu = (bf16*)(F.ws + WS_RA); bf16* Wdn = (bf16*)(F.ws + WS_WDN); bf16* hn = (bf16*)(F.ws + WS_HN);
    constexpr int I_GU = (NGU_T / 32) * 64, I_DN = 128 * 172;
    for (int it = gw; it < I_GU + I_DN; it += NGW) {
        int r = it;
        if (r < I_GU) { const int nb = r >> 6, kb = r & 63, drow = nb * 32, tl = drow >> 8, w = drow & 255;
            const float* W = (w < 128) ? F.in[I_WFG] : F.in[I_WFU]; const int src = tl * 128 + (w & 127);
            tr_item(W + (size_t)(kb * 64) * DFF + src, DFF, 32, 1.f, Wgu + (size_t)drow * DM + kb * 64, DM, scr, lane); continue; } r -= I_GU;
        { const int nb = r / 172, kb = r % 172;
            tr_item(F.in[I_WFD] + (size_t)(kb * 64) * DM + nb * 32, DM, 32, 1.f, Wdn + (size_t)(nb * 32) * DFF + kb * 64, DFF, scr, lane); }
    }
    for (int m = gw; m < T; m += NGW) rms_row_to_bf16(F.out + (size_t)m * DM, F.in[I_GFFN], hn + (size_t)m * DM, lane);
}
__device__ __forceinline__ void ph11_final(Frame& F) {
    int tid_ = threadIdx.x; asm volatile("" : "+v"(tid_)); const int tid = tid_, lane = tid & 63; (void)lane;
    const int gw = F.vcu * NWAVES + F.wave, NGW = F.G * NWAVES;
    for (int m = gw; m < T; m += NGW) {
        f32x4* xr = (f32x4*)(F.out + (size_t)m * DM) + lane; const f32x4* gr = (const f32x4*)F.in[I_GFINAL] + lane;
        f32x4 v[16]; float s = 0.f;
#pragma unroll
        for (int j = 0; j < 16; ++j) { v[j] = xr[64 * j]; s += (v[j].x * v[j].x + v[j].y * v[j].y) + (v[j].z * v[j].z + v[j].w * v[j].w); }
        const float rstd = rsqrtf(wave_sum(s) * (1.f / DM) + EPS);
#pragma unroll
        for (int j = 0; j < 16; ++j) xr[64 * j] = v[j] * rstd * gr[64 * j];
    }
}

#ifndef MK_ONE_LAUNCH
#define MK_ONE_LAUNCH 1
#endif
constexpr int N_PHASES = 12;
struct Args { const float* in[25]; float* out; unsigned char* ws; int ph_lo, ph_hi; };
__global__ void __launch_bounds__(NTHR, 2) fwd_kernel(Args args) {
    extern __shared__ __attribute__((aligned(16))) unsigned char lds[];
    Frame F;
    F.lds = (LAS unsigned char*)lds;
    F.wave = __builtin_amdgcn_readfirstlane((int)threadIdx.x >> 6);
    F.G = gridDim.x; { const int bx = blockIdx.x; F.vcu = (F.G % 8 == 0) ? (bx % 8) * (F.G / 8) + bx / 8 : bx; }
#pragma unroll
    for (int i = 0; i < 25; ++i) F.in[i] = args.in[i];
    F.out = args.out; F.ws = args.ws;
    volatile LAS unsigned* MISC = (volatile LAS unsigned*)(F.lds + MISC_OFF);
    for (int u = threadIdx.x; u < (LDS_BYTES - LDSCTL_OFF) / 4; u += NTHR) ((LAS unsigned*)(F.lds + LDSCTL_OFF))[u] = 0u;
    __syncthreads();
    const int lo = args.ph_lo, hi = args.ph_hi;
    XcdBarrier bar; bar.bar = (unsigned*)(F.ws + WS_CTL) + CW_BAR; bar.x = 0; bar.st = nullptr;
    if (hi - lo > 1) bar = xcd_barrier_post((unsigned*)(F.ws + WS_CTL) + CW_BAR, MISC + 8);
#ifndef PH_MASK
#define PH_MASK 0xfff
#endif
#define IN(k) (((PH_MASK >> (k)) & 1) && lo <= (k) && (k) < hi)
#define SEAM(k) do { if (lo <= (k) && (k) + 1 < hi) xcd_barrier(bar); } while (0)

    if (IN(0)) { ph0_prologue(F); } SEAM(0);

    if (IN(1)) {
        pg8::MultiOrder S; S.init(DM, F.G, (int)blockIdx.x);
        const bf16* xn = (const bf16*)((unsigned char*)F.out + OY_XN); const bf16* Wint = (const bf16*)(F.ws + WS_RA);
        S.add(xn, Wint, T, NIN_T); S.add(Wint + (size_t)2048 * DM, xn, GV, T); S.add(F.ws + WS_MEMN, F.ws + WS_WKV, 512, 2048); S.add(F.ws + WS_WKV + (size_t)1024 * DM * 2, F.ws + WS_MEMN, 1024, 512);
        pg8::EpiZ E{(bf16*)(F.ws + WS_ZS), (float*)(F.ws + WS_ALR), (bf16*)(F.ws + WS_GATES), F.in[I_BMERGE], (bf16*)(F.ws + WS_VT), F.out + O_MKP, F.out + O_MVP, (bf16*)(F.ws + WS_MKV), (bf16*)(F.ws + WS_MVT)};
        pg8::gemm_phase<pg8::EpiZ, pg8::MultiOrder, true, true>(F.lds, DM, S, E);
    } SEAM(1);

    if (IN(2)) { ph_g0(F); ph_conv(F); } SEAM(2);
    if (IN(3)) { ph_g1(F); ph_xattn(F); } SEAM(3);
    if (IN(4)) { ph_g2(F); } SEAM(4);
    if (IN(5)) { ph_g3(F); } SEAM(5);

    if (IN(6)) {
        pg8::StaticOrder S; S.init1((unsigned char*)F.out + OY_BR, F.ws + WS_WBR, T, DM, DM, F.G, (int)blockIdx.x);
        pg8::EpiMix E{(const bf16*)(F.ws + WS_GATES), (bf16*)(F.ws + WS_MIX)};
        pg8::gemm_phase<pg8::EpiMix, pg8::StaticOrder, true, true>(F.lds, DM, S, E);
    } SEAM(6);

    if (IN(7)) {
        pg8::StaticOrder S; S.init1(F.ws + WS_MIX, F.ws + WS_WOUT, T, DM, DM, F.G, (int)blockIdx.x);
        pg8::EpiX1 E{F.in[I_XP], F.in[I_XS], F.out};
        pg8::gemm_phase<pg8::EpiX1, pg8::StaticOrder, true, true>(F.lds, DM, S, E);
    } SEAM(7);

    if (IN(8)) { ph8_hn_ffnw(F); } SEAM(8);

    if (IN(9)) {
        pg8::StaticOrder S; S.init1(F.ws + WS_HN, F.ws + WS_RA, T, NGU_T, DM, F.G, (int)blockIdx.x);
        pg8::EpiGU E{(bf16*)(F.ws + WS_GATES)};
        pg8::gemm_phase<pg8::EpiGU, pg8::StaticOrder, true, true>(F.lds, DM, S, E);
    } SEAM(9);

    if (IN(10)) {
        pg8::StaticOrder S; S.init1(F.ws + WS_GATES, F.ws + WS_WDN, T, DM, DFF, F.G, (int)blockIdx.x);
        pg8::EpiDown E{F.out};
        pg8::gemm_phase<pg8::EpiDown, pg8::StaticOrder, true, true>(F.lds, DFF, S, E);
    } SEAM(10);

    if (IN(11)) { ph11_final(F); }
#undef IN
#undef SEAM
}

extern "C" void kernel_launch(void* const* d_in, const int* in_sizes, int n_in, void* d_out, int out_size, void* d_ws, size_t ws_size, hipStream_t stream) {
    static int grid = 0;
    if (grid == 0) {
        if (n_in != 25 || in_sizes[0] != TP * DM || out_size != 94441472 || ws_size < WS_END) { fprintf(stderr, "kernel_launch: unexpected problem shape (n_in %d, out %d, ws %zu); nothing launched\n", n_in, out_size, ws_size); grid = -1; return; }
        int dev = 0, cus = 0, per_cu = 0;
        if (hipGetDevice(&dev) != hipSuccess || hipDeviceGetAttribute(&cus, hipDeviceAttributeMultiprocessorCount, dev) != hipSuccess) { grid = -1; return; }
        if (hipFuncSetAttribute((const void*)fwd_kernel, hipFuncAttributeMaxDynamicSharedMemorySize, LDS_BYTES) != hipSuccess) { fprintf(stderr, "kernel_launch: hipFuncSetAttribute failed\n"); grid = -1; return; }
        if (hipOccupancyMaxActiveBlocksPerMultiprocessor(&per_cu, (const void*)fwd_kernel, NTHR, LDS_BYTES) != hipSuccess || per_cu < 1) { fprintf(stderr, "kernel_launch: occupancy query says %d blocks per CU\n", per_cu); }
        (void)hipGetLastError();
        grid = cus;
    }
    if (grid < 0) return;
    if (hipMemsetAsync((char*)d_ws + WS_CTL, 0, CTL_ZERO_BYTES, stream) != hipSuccess) return;
    Args a{};
    for (int i = 0; i < 25; ++i) a.in[i] = (const float*)d_in[i];
    a.out = (float*)d_out; a.ws = (unsigned char*)d_ws;
#if MK_ONE_LAUNCH
    a.ph_lo = 0; a.ph_hi = N_PHASES;
    hipLaunchKernelGGL(fwd_kernel, dim3(grid), dim3(NTHR), LDS_BYTES, stream, a);
#else
    for (int p = 0; p < N_PHASES; ++p) { a.ph_lo = p; a.ph_hi = p + 1; hipLaunchKernelGGL(fwd_kernel, dim3(grid), dim3(NTHR), LDS_BYTES, stream, a); }
#endif
}
```

```cpp
#include <hip/hip_runtime.h>
#include <cstdio>
#include <cstdint>

namespace pg8 {
#define PG8_LAS __attribute__((address_space(3)))
typedef unsigned short bf16_t;
typedef short bf16x8 __attribute__((ext_vector_type(8)));
typedef float f32x4 __attribute__((ext_vector_type(4)));
typedef unsigned u32x4 __attribute__((ext_vector_type(4)));
constexpr int BM = 256, BK = 64, HALF = 128, HTB = HALF * BK * 2  , STAGE_BYTES = 8 * HTB, NXCD = 8, WGM = 8;

__host__ __device__ __forceinline__ int lds_byte(int r, int c) { const int st = (r >> 4) * 2 + (c >> 5), rr = r & 15, cc = c & 31, ob = rr * 64 + cc * 2; return st * 1024 + (ob ^ (((ob >> 9) & 1) << 5)); }
__host__ __device__ __forceinline__ void stage_rc(int b, int& R, int& C) { const int st = b / 1024, sb = b % 1024, swz = sb ^ (((sb >> 9) & 1) << 5); R = (st >> 1) * 16 + swz / 64; C = (st & 1) * 32 + (swz % 64) / 2; }
__host__ __device__ __forceinline__ int perm32(int rho) { const int n = rho >> 4, i = rho & 15; return 8 * (i >> 2) + 4 * n + (i & 3); }

struct Unit { int pm, pn, prob; const char* a; const char* b; };

struct Prob { const char* A; const char* B; int nM, nN; };
struct MultiOrder {
    Prob p[4]; int np, G, c; size_t tstep;
    __host__ __device__ void init(int K, int G_, int c_) { np = 0; G = G_; c = c_; tstep = (size_t)BM * K * 2; }
    __host__ __device__ void add(const void* A, const void* B, int M, int N) { p[np].A = (const char*)A; p[np].B = (const char*)B; p[np].nM = M / BM; p[np].nN = N / BM; ++np; }
    __host__ __device__ bool next(int i, Unit& u) const {
        long L = (long)i * G + c; if (c < 0) return false;
#pragma unroll
        for (int q = 0; q < 4; ++q) { if (q >= np) break;
            const int nM = p[q].nM, nN = p[q].nN, nwg = nM * nN;
            if (L < nwg) {
                int wgid = (int)L; { const int qq = nwg / NXCD, r = nwg % NXCD, xcd = wgid % NXCD, off = wgid / NXCD; wgid = (xcd < r ? xcd * (qq + 1) : r * (qq + 1) + (xcd - r) * qq) + off; }
                const int nig = WGM * nN, gid = wgid / nig, fm = gid * WGM, gsz = (nM - fm) < WGM ? (nM - fm) : WGM;
                u.pm = fm + ((wgid % nig) % gsz); u.pn = (wgid % nig) / gsz; u.prob = q;
                u.a = p[q].A + (size_t)u.pm * tstep; u.b = p[q].B + (size_t)u.pn * tstep; return true; }
            L -= nwg; }
        return false;
    }
    __device__ __forceinline__ void a_ready(const Unit&) const {}
    __device__ __forceinline__ void done(const Unit&) const {}
};
struct StaticOrder : MultiOrder {
    __host__ __device__ void init1(const void* A, const void* B, int M, int N, int K, int G_, int c_) { init(K, G_, c_); add(A, B, M, N); }
};

typedef __bf16 bf16x2_t __attribute__((ext_vector_type(2)));
typedef float f32x2_t __attribute__((ext_vector_type(2)));
__device__ __forceinline__ unsigned cvt_pk_bf16(float lo, float hi) { const f32x2_t f = {lo, hi}; const bf16x2_t b = __builtin_convertvector(f, bf16x2_t); return __builtin_bit_cast(unsigned, b); }

template <class Epi, class Sched, bool ALIGN_EPI = false, bool SP2 = false>
__device__ __forceinline__ void gemm_phase(PG8_LAS unsigned char* lds, const int K, const Sched& S, const Epi& E) {
    int tid_ = threadIdx.x; asm volatile("" : "+v"(tid_)); const int tid = tid_, wid = __builtin_amdgcn_readfirstlane(tid >> 6), lane = tid & 63, wr = wid >> 2, wc = wid & 3, fr = lane & 15, fq = lane >> 4;
    const int nt = K / BK;
    unsigned voffA[2], voffB[2];
#pragma unroll
    for (int i = 0; i < 2; ++i) { int R, C; stage_rc(tid * 16 + i * 8192, R, C); const int Rb = Epi::PERM ? ((R & ~31) + perm32(R & 31)) : R;
        voffA[i] = (unsigned)(R * K + C) * 2u; voffB[i] = (unsigned)(Rb * K + C) * 2u; }
    const size_t kstep = (size_t)(BK * 2);
    const size_t hstep = (size_t)HALF * K * 2;
    const unsigned ldsw = (unsigned)wid * 1024u;
    const int aoff = lds_byte(wr * 64 + fr, fq * 8), boff = lds_byte(wc * 32 + fr, fq * 8);
#define PG8_SA(b, h) (((b) * 2 + (h)) * HTB)
#define PG8_SB(b, h) ((4 + (b) * 2 + (h)) * HTB)
#define PG8_STAGE(bufoff, gbase, voff) do { _Pragma("unroll") for (int _i = 0; _i < 2; ++_i) \
        __builtin_amdgcn_global_load_lds((const unsigned*)((const char*)(gbase) + (voff)[_i]), (PG8_LAS unsigned*)(lds + (bufoff) + ldsw + _i * 8192), 16, 0, 0); } while (0)
#define PG8_LDA(dst, b, h) do { _Pragma("unroll") for (int m = 0; m < 4; ++m) _Pragma("unroll") for (int k = 0; k < 2; ++k) dst[m][k] = *(const PG8_LAS bf16x8*)(lds + PG8_SA(b, h) + aoff + m * 2048 + k * 1024); } while (0)
#define PG8_LDB(dst, b, h) do { _Pragma("unroll") for (int n = 0; n < 2; ++n) _Pragma("unroll") for (int k = 0; k < 2; ++k) dst[n][k] = *(const PG8_LAS bf16x8*)(lds + PG8_SB(b, h) + boff + n * 2048 + k * 1024); } while (0)
#define PG8_MMA(ai, bj, At, Bt) do { __builtin_amdgcn_s_setprio(1); _Pragma("unroll") for (int m = 0; m < 4; ++m) _Pragma("unroll") for (int n = 0; n < 2; ++n) _Pragma("unroll") for (int k = 0; k < 2; ++k) \
        acc[ai][bj][m][n] = __builtin_amdgcn_mfma_f32_16x16x32_bf16(Bt[n][k], At[m][k], acc[ai][bj][m][n], 0, 0, 0); __builtin_amdgcn_s_setprio(0); } while (0)
#define PG8_WAIT_V(n) asm volatile("s_waitcnt vmcnt(" #n ")" ::: "memory")
#define PG8_WAIT_L(n) asm volatile("s_waitcnt lgkmcnt(" #n ")" ::: "memory")
#define PG8_BAR __builtin_amdgcn_s_barrier()
#define PG8_SCHED __builtin_amdgcn_sched_barrier(0)
    Unit cur, nxt; int ui = 0;
    if (!S.next(0, cur)) return;
    f32x4 acc[2][2][4][2];
#pragma unroll
    for (int a = 0; a < 2; ++a)
#pragma unroll
        for (int b = 0; b < 2; ++b)
#pragma unroll
            for (int m = 0; m < 4; ++m)
#pragma unroll
                for (int n = 0; n < 2; ++n) acc[a][b][m][n] = (f32x4){0.f, 0.f, 0.f, 0.f};
    bf16x8 At[4][2], B0[2][2], B1[2][2];
    const char* cA = cur.a; const char* cB = cur.b;
    S.a_ready(cur);
    if constexpr (SP2) {
        PG8_STAGE(PG8_SB(0, 0), cB, voffB); PG8_STAGE(PG8_SB(0, 1), cB + hstep, voffB); PG8_STAGE(PG8_SA(0, 0), cA, voffA); PG8_STAGE(PG8_SA(0, 1), cA + hstep, voffA);
        if (wr == 1) PG8_BAR;
        PG8_WAIT_V(2); PG8_BAR;
        PG8_STAGE(PG8_SB(1, 0), cB + kstep, voffB); PG8_STAGE(PG8_SA(1, 0), cA + kstep, voffA); PG8_STAGE(PG8_SB(1, 1), cB + hstep + kstep, voffB);
        PG8_WAIT_V(6); PG8_BAR;
    } else {
        PG8_STAGE(PG8_SB(0, 0), cB, voffB); PG8_STAGE(PG8_SA(0, 0), cA, voffA); PG8_STAGE(PG8_SB(0, 1), cB + hstep, voffB); PG8_STAGE(PG8_SA(0, 1), cA + hstep, voffA);
        if (wr == 1) PG8_BAR;
        PG8_WAIT_V(4); PG8_BAR;
        PG8_STAGE(PG8_SB(1, 0), cB + kstep, voffB); PG8_STAGE(PG8_SA(1, 0), cA + kstep, voffA); PG8_STAGE(PG8_SB(1, 1), cB + hstep + kstep, voffB);
        PG8_WAIT_V(6); PG8_BAR;
    }
    for (;;) {
        const bool has_next = S.next(ui + 1, nxt);
        const char* nA = has_next ? nxt.a : cA; const char* nB = has_next ? nxt.b : cB;
        for (int t = 0; t < nt; t += 2) {
            const bool last = (t == nt - 2);
            const char* a1 = cA + (size_t)(t + 1) * kstep;
            const char* a2 = last ? nA : cA + (size_t)(t + 2) * kstep; const char* b2 = last ? nB : cB + (size_t)(t + 2) * kstep;
            const char* a3 = a2 + kstep; const char* b3 = b2 + kstep;
            if (last && has_next) S.a_ready(nxt);
            if constexpr (Epi::KHOOK) { if (t == 32 || t == 48) { if (wr == 0) PG8_BAR;
                E.khook(acc, cur, t == 32 ? 0 : 1, wr, wc, fr, fq); if (wr == 1) PG8_BAR; } }
            if constexpr (SP2) {
            PG8_LDB(B0, 0, 0); PG8_LDB(B1, 0, 1); PG8_SCHED; PG8_LDA(At, 0, 0); PG8_STAGE(PG8_SA(1, 1), a1 + hstep, voffA);
            PG8_WAIT_V(8); PG8_WAIT_L(0); PG8_BAR; PG8_MMA(0, 0, At, B0); PG8_MMA(0, 1, At, B1); PG8_BAR; PG8_SCHED;
            PG8_LDA(At, 0, 1); PG8_STAGE(PG8_SB(0, 0), b2, voffB); PG8_STAGE(PG8_SB(0, 1), b2 + hstep, voffB); PG8_STAGE(PG8_SA(0, 0), a2, voffA);
            PG8_WAIT_V(8); PG8_WAIT_L(0); PG8_BAR; PG8_MMA(1, 0, At, B0); PG8_MMA(1, 1, At, B1); PG8_BAR; PG8_SCHED;
            PG8_LDB(B0, 1, 0); PG8_LDB(B1, 1, 1); PG8_SCHED; PG8_LDA(At, 1, 0); PG8_STAGE(PG8_SA(0, 1), a2 + hstep, voffA);
            PG8_WAIT_V(8); PG8_WAIT_L(0); PG8_BAR; PG8_MMA(0, 0, At, B0); PG8_MMA(0, 1, At, B1); PG8_BAR; PG8_SCHED;
            PG8_LDA(At, 1, 1); PG8_STAGE(PG8_SB(1, 0), b3, voffB); PG8_STAGE(PG8_SB(1, 1), b3 + hstep, voffB); PG8_STAGE(PG8_SA(1, 0), a3, voffA);
            PG8_WAIT_V(8); PG8_WAIT_L(0); PG8_BAR; PG8_MMA(1, 0, At, B0); PG8_MMA(1, 1, At, B1); PG8_BAR; PG8_SCHED;
            } else {
            PG8_LDB(B0, 0, 0); PG8_SCHED; PG8_LDA(At, 0, 0); PG8_STAGE(PG8_SA(1, 1), a1 + hstep, voffA);
            PG8_WAIT_L(8); PG8_BAR; PG8_WAIT_L(0); PG8_MMA(0, 0, At, B0); PG8_BAR; PG8_SCHED;
            PG8_LDB(B1, 0, 1); PG8_STAGE(PG8_SB(0, 0), b2, voffB);
            PG8_BAR; PG8_WAIT_L(0); PG8_MMA(0, 1, At, B1); PG8_BAR;
            PG8_LDA(At, 0, 1); PG8_STAGE(PG8_SA(0, 0), a2, voffA);
            PG8_BAR; PG8_WAIT_L(0); PG8_MMA(1, 0, At, B0); PG8_BAR; PG8_SCHED;
            PG8_STAGE(PG8_SB(0, 1), b2 + hstep, voffB);
            PG8_WAIT_V(6); PG8_BAR; PG8_MMA(1, 1, At, B1); PG8_BAR;
            PG8_LDB(B0, 1, 0); PG8_SCHED; PG8_LDA(At, 1, 0); PG8_STAGE(PG8_SA(0, 1), a2 + hstep, voffA);
            PG8_WAIT_L(8); PG8_BAR; PG8_WAIT_L(0); PG8_MMA(0, 0, At, B0); PG8_BAR; PG8_SCHED;
            PG8_LDB(B1, 1, 1); PG8_STAGE(PG8_SB(1, 0), b3, voffB);
            PG8_BAR; PG8_WAIT_L(0); PG8_MMA(0, 1, At, B1); PG8_BAR;
            PG8_LDA(At, 1, 1); PG8_STAGE(PG8_SA(1, 0), a3, voffA);
            PG8_BAR; PG8_WAIT_L(0); PG8_MMA(1, 0, At, B0); PG8_BAR; PG8_SCHED;
            PG8_STAGE(PG8_SB(1, 1), b3 + hstep, voffB);
            PG8_WAIT_V(6); PG8_BAR; PG8_MMA(1, 1, At, B1); PG8_BAR;
            }
        }
        if constexpr (ALIGN_EPI) { if (wr == 0) PG8_BAR; }
        E(acc, cur, wr, wc, fr, fq); S.done(cur);
        if (!has_next) break;
#pragma unroll
        for (int a = 0; a < 2; ++a)
#pragma unroll
            for (int b = 0; b < 2; ++b)
#pragma unroll
                for (int m = 0; m < 4; ++m)
#pragma unroll
                    for (int n = 0; n < 2; ++n) acc[a][b][m][n] = (f32x4){0.f, 0.f, 0.f, 0.f};
        cur = nxt; cA = nA; cB = nB; ++ui;
        if constexpr (ALIGN_EPI) { if (wr == 1) PG8_BAR; }
    }
    PG8_WAIT_V(0);
    if constexpr (!ALIGN_EPI) { if (wr == 0) PG8_BAR; }
    PG8_BAR;
#undef PG8_SA
#undef PG8_SB
#undef PG8_STAGE
#undef PG8_LDA
#undef PG8_LDB
#undef PG8_MMA
#undef PG8_WAIT_V
#undef PG8_WAIT_L
#undef PG8_BAR
#undef PG8_SCHED
}
}

constexpr int NWAVES = 8, NTHR = NWAVES * 64;
constexpr int DM = 4096, TP = 2 * 8192, TS = 32 * 64, T = TP + TS;
constexpr int SEQP = 8192, NCHK = T / 64, NCHK_P = TP / 64;
constexpr int GK = 1024, GV = 2048, DK = 256, DV = 512, NH = 4, RANK = 16;
constexpr int CW = 1024, XW = 1024, XDH = 256, NMEM = 256, DFF = 11008;
constexpr int IN_COLS = 22544;
constexpr int ZS_LD = 8192, G_LD = 12288;
constexpr int ZQ = 0, ZK = 1024, ZR = 2048, ZCB = 4096, ZCC = 5120, ZCH = 6144, ZXQ = 7168;
constexpr int NMAIN = 20480, WV_ROW = 20480, WA_ROW = 22528;
constexpr int NGU_T = 22016;
constexpr float EPS = 1e-6f;
constexpr size_t O_Y = 0, O_SGP = 75497472, O_CCP = 76546048, O_MKP = 76550144, O_MVP = 77074432, O_SGS = 77598720, O_CCS = 94375936;
constexpr size_t MiB = 1u << 20;
constexpr size_t WS_CTL = 0, CTL_ZERO_BYTES = 1 * MiB;
constexpr size_t WS_RA = 1 * MiB;
constexpr size_t WS_DS0 = WS_RA, WS_DSS = WS_RA + 128 * MiB;
constexpr size_t WS_WBR = 180 * MiB, WS_WOUT = 212 * MiB, WS_WKV = 244 * MiB;
constexpr size_t WS_ZS = 260 * MiB;
constexpr size_t WS_MIX = WS_ZS, WS_HN = WS_ZS + 144 * MiB;
constexpr size_t WS_GATES = 548 * MiB;
constexpr size_t WS_DS1 = 980 * MiB;
constexpr size_t WS_MKV = 1108 * MiB;
constexpr size_t WS_ALR = 1142 * MiB, WS_MEMN = 1144 * MiB, WS_AOUT = 1148 * MiB, WS_WDN = 1150 * MiB;
constexpr size_t WS_VT = 1236 * MiB;
constexpr size_t WS_KINT = 1308 * MiB;
constexpr size_t WS_MVT = 1344 * MiB;
constexpr size_t WS_END = 1361 * MiB;
constexpr size_t OY_XN = 0, OY_BR = (size_t)T * DM * 2;

constexpr int CW_BAR = 4096;
constexpr int RING_BYTES = 131072, LDSCTL_OFF = RING_BYTES, MISC_OFF = LDSCTL_OFF + 320, LDS_BYTES = 147456;

#define GAS __attribute__((address_space(1)))
#define LAS __attribute__((address_space(3)))
typedef unsigned short bf16;
typedef unsigned v4u __attribute__((ext_vector_type(4)));
typedef unsigned v2u __attribute__((ext_vector_type(2)));
typedef float f32x4 __attribute__((ext_vector_type(4)));
#define LDS_WAIT() asm volatile("s_waitcnt lgkmcnt(0)" ::: "memory")
#define VM_WAIT() asm volatile("s_waitcnt vmcnt(0)" ::: "memory")
__device__ __forceinline__ float bf_lo(unsigned w) { return __uint_as_float(w << 16); }
__device__ __forceinline__ float bf_hi(unsigned w) { return __uint_as_float(w & 0xffff0000u); }
__device__ __forceinline__ float bf1(bf16 b) { return __uint_as_float(((unsigned)b) << 16); }
__device__ __forceinline__ unsigned pk2(float lo, float hi) { return pg8::cvt_pk_bf16(lo, hi); }
__device__ __forceinline__ bf16 f2bf1(float f) { return (bf16)(pg8::cvt_pk_bf16(f, 0.f) & 0xffffu); }
__device__ __forceinline__ void unpack8(const v4u w, float (&f)[8]) { f[0] = bf_lo(w.x); f[1] = bf_hi(w.x); f[2] = bf_lo(w.y); f[3] = bf_hi(w.y); f[4] = bf_lo(w.z); f[5] = bf_hi(w.z); f[6] = bf_lo(w.w); f[7] = bf_hi(w.w); }
__device__ __forceinline__ v4u pack8(const float (&f)[8]) { v4u w; w.x = pk2(f[0], f[1]); w.y = pk2(f[2], f[3]); w.z = pk2(f[4], f[5]); w.w = pk2(f[6], f[7]); return w; }
__device__ __forceinline__ float sigmoidf_(float x) { return __builtin_amdgcn_rcpf(1.f + __expf(-x)); }
__device__ __forceinline__ float wave_sum(float v) {
#pragma unroll
    for (int o = 1; o < 64; o <<= 1) v += __shfl_xor(v, o);
    return v;
}
__device__ __forceinline__ float wave_max(float v) {
#pragma unroll
    for (int o = 1; o < 64; o <<= 1) v = fmaxf(v, __shfl_xor(v, o));
    return v;
}

#define XB_TMO      128
#define XB_XCNT(j)  (256  + 64 * (j))
#define XB_XSUB(j)  (1280 + 64 * (j))
#define XB_XGEN(j)  (2304 + 64 * (j))
#define XB_TOP      3328
#define XB_TOPGEN   3392
#define XCD_BAR_WORDS 3456
#define XB_SPIN_CAP (1u << 22)
__device__ __forceinline__ unsigned xb_ld(unsigned* p)              { return __hip_atomic_load(p, __ATOMIC_RELAXED, __HIP_MEMORY_SCOPE_AGENT); }
__device__ __forceinline__ unsigned xb_add(unsigned* p, unsigned v) { return __hip_atomic_fetch_add(p, v, __ATOMIC_RELAXED, __HIP_MEMORY_SCOPE_AGENT); }
__device__ __forceinline__ unsigned xb_xcc_id() { return (unsigned)__builtin_amdgcn_s_getreg((3 << 11) | 20) & 0xFu; }
#define XB_SPIN(cond, bar) do { unsigned _sp = 0; while (cond) { __builtin_amdgcn_s_sleep(1); \
    if ((++_sp & 255u) == 0u) { if (xb_ld(&(bar)[XB_TMO])) break; if (_sp > XB_SPIN_CAP) { atomicAdd(&(bar)[XB_TMO], 1u); break; } } } } while (0)
struct XcdBarrier { unsigned* bar; unsigned x; volatile LAS unsigned* st; };
__device__ __forceinline__ XcdBarrier xcd_barrier_post(unsigned* bar, volatile LAS unsigned* st) {
    XcdBarrier b; b.bar = bar; b.x = xb_xcc_id(); b.st = st;
    if (threadIdx.x == 0) (void)xb_add(&bar[XB_XCNT(b.x)], 1u);
    return b;
}
__device__ __forceinline__ void xcd_barrier_complete(unsigned* bar, unsigned x, unsigned& nloc, unsigned& nx) {
    const unsigned G = gridDim.x * gridDim.y * gridDim.z;
    unsigned sum, cnt, mine, sp = 0u;
    for (;;) {
        sum = 0u; cnt = 0u; mine = 0u;
#pragma unroll
        for (unsigned j = 0; j < 16; ++j) { const unsigned c = xb_ld(&bar[XB_XCNT(j)]); sum += c; cnt += (c > 0u) ? 1u : 0u; mine = (j == x) ? c : mine; }
        if (sum == G) break;
        __builtin_amdgcn_s_sleep(1);
        if ((++sp & 255u) == 0u) { if (xb_ld(&bar[XB_TMO])) break; if (sp > XB_SPIN_CAP) { atomicAdd(&bar[XB_TMO], 1u); break; } }
    }
    nloc = mine > 0u ? mine : 1u; nx = cnt > 0u ? cnt : 1u;
}
__device__ __forceinline__ void xcd_barrier(const XcdBarrier& b) {
    asm volatile("s_waitcnt vmcnt(0)" ::: "memory");
    __syncthreads();
    if (threadIdx.x == 0) {
        unsigned* bar = b.bar;
        __builtin_amdgcn_s_waitcnt(0);
        unsigned nloc = b.st[0], nx = b.st[1];
        if (nloc == 0u) { xcd_barrier_complete(bar, b.x, nloc, nx); b.st[0] = nloc; b.st[1] = nx; }
        const unsigned old = xb_add(&bar[XB_XSUB(b.x)], 1u);
        const unsigned gen = old / nloc;
        if (old + 1u == (gen + 1u) * nloc) {
            __builtin_amdgcn_fence(__ATOMIC_RELEASE, "agent");
            asm volatile("s_waitcnt vmcnt(0)" ::: "memory");
            const unsigned og = xb_add(&bar[XB_TOP], 1u);
            const unsigned tg = og / nx;
            if (og + 1u == (tg + 1u) * nx) xb_add(&bar[XB_TOPGEN], 1u);
            else XB_SPIN(xb_ld(&bar[XB_TOPGEN]) == tg, bar);
            __builtin_amdgcn_fence(__ATOMIC_ACQUIRE, "agent");
            xb_add(&bar[XB_XGEN(b.x)], 1u);
            asm volatile("s_waitcnt vmcnt(0)" ::: "memory");
        } else {
            XB_SPIN(xb_ld(&bar[XB_XGEN(b.x)]) == gen, bar);
            __builtin_amdgcn_fence(__ATOMIC_ACQUIRE, "agent");
            asm volatile("s_waitcnt vmcnt(0)" ::: "memory");
        }
    }
    __syncthreads();
}

struct Frame {
    LAS unsigned char* lds;
    int wave, vcu, G;
    const float* in[25];
    float* out; unsigned char* ws;
};
enum InIdx { I_XP = 0, I_XS, I_SGLA, I_CCONV, I_CMK, I_CMV, I_MEMP, I_GMIX, I_WIN, I_WA2, I_BA, I_GGLA, I_WGLAO, I_WCONV, I_WCONVO, I_WXAO, I_GMEM, I_WMEMKV, I_BMERGE, I_WOUT, I_GFFN, I_WFG, I_WFU, I_WFD, I_GFINAL };

__device__ __forceinline__ const float* xrow_ptr(const Frame& F, int row) { return row < TP ? F.in[I_XP] + (size_t)row * DM : F.in[I_XS] + (size_t)(row - TP) * DM; }
__device__ __forceinline__ void chunk_seq(int ci, int& seq, int& cis) { if (ci < NCHK_P) { seq = ci >> 7; cis = ci & 127; } else { seq = 2 + (ci - NCHK_P); cis = 0; } }
__device__ __forceinline__ bf16* slot_ptr(const Frame& F, int ci, int h) {
    if (ci < 128) return (bf16*)(F.ws + WS_DS0) + ((size_t)(ci * NH + h) << 17);
    if (ci < 256) return (bf16*)(F.ws + WS_DS1) + ((size_t)((ci - 128) * NH + h) << 17);
    return (bf16*)(F.ws + WS_DSS) + ((size_t)((ci - 256) * NH + h) << 17);
}

__device__ __forceinline__ void tr_item(const float* Wp, size_t ldw, int nvalid, float scale, bf16* WTp, size_t ldt, LAS float* scr, int lane) {
    const int n = lane & 31;
#pragma unroll 8
    for (int i = 0; i < 32; ++i) { const int kk = 2 * i + (lane >> 5); scr[kk * 33 + n] = (n < nvalid) ? Wp[(size_t)kk * ldw + n] * scale : 0.f; }
    LDS_WAIT(); asm volatile("" ::: "memory");
    const int c = lane & 7;
#pragma unroll
    for (int j = 0; j < 4; ++j) { const int nn = (lane >> 3) + 8 * j; const LAS float* s = scr + (8 * c) * 33 + nn;
        v4u o; o.x = pk2(s[0 * 33], s[1 * 33]); o.y = pk2(s[2 * 33], s[3 * 33]); o.z = pk2(s[4 * 33], s[5 * 33]); o.w = pk2(s[6 * 33], s[7 * 33]);
        *(v4u*)(WTp + (size_t)nn * ldt + 8 * c) = o; }
    LDS_WAIT(); asm volatile("" ::: "memory");
}
__device__ __forceinline__ void rms_row_to_bf16(const float* xrow, const float* g, bf16* orow, int lane) {
    const f32x4* xr = (const f32x4*)xrow + lane; const f32x4* gr = (const f32x4*)g + lane;
    f32x4 v[16]; float s = 0.f;
#pragma unroll
    for (int j = 0; j < 16; ++j) { v[j] = xr[64 * j]; s += (v[j].x * v[j].x + v[j].y * v[j].y) + (v[j].z * v[j].z + v[j].w * v[j].w); }
    const float rstd = rsqrtf(wave_sum(s) * (1.f / DM) + EPS);
    v2u* o8 = (v2u*)orow + lane;
#pragma unroll
    for (int j = 0; j < 16; ++j) { const f32x4 gg = gr[64 * j]; v2u w; w.x = pk2(v[j].x * rstd * gg.x, v[j].y * rstd * gg.y); w.y = pk2(v[j].z * rstd * gg.z, v[j].w * rstd * gg.w); o8[64 * j] = w; }
}

namespace pg8 {
struct EpiZ {
    static constexpr bool PERM = true, KHOOK = false;
    bf16_t* zs; bf16_t* gates; const float* bmerge; bf16_t* vT; float* outk; float* outv; bf16_t* mkv; bf16_t* mvT;
    __device__ __forceinline__ void operator()(const f32x4 (&acc)[2][2][4][2], const Unit& u, int wr, int wc, int fr, int fq) const {
        const int row0 = u.pm * BM + wr * 64 + fr;
        if (u.prob == 1) {
            const int col0 = u.pn * BM + wc * 32 + 8 * fq;
#pragma unroll
            for (int ai = 0; ai < 2; ++ai)
#pragma unroll
                for (int m = 0; m < 4; ++m) { bf16_t* rowp = vT + (size_t)(row0 + ai * HALF + m * 16) * T + col0;
#pragma unroll
                    for (int bj = 0; bj < 2; ++bj) { const f32x4 v0 = acc[ai][bj][m][0], v1 = acc[ai][bj][m][1];
                        u32x4 w; w.x = cvt_pk_bf16(v0[0], v0[1]); w.y = cvt_pk_bf16(v0[2], v0[3]); w.z = cvt_pk_bf16(v1[0], v1[1]); w.w = cvt_pk_bf16(v1[2], v1[3]);
                        *(u32x4*)(rowp + bj * HALF) = w; } }
        } else if (u.prob == 3) {
            const int col0 = wc * 32 + 8 * fq; bf16_t* tb = mvT + (size_t)(u.pn * NH + u.pm) * 65536;
#pragma unroll
            for (int ai = 0; ai < 2; ++ai)
#pragma unroll
                for (int m = 0; m < 4; ++m) { bf16_t* rowp = tb + (size_t)(wr * 64 + fr + ai * HALF + m * 16) * 256 + col0;
#pragma unroll
                    for (int bj = 0; bj < 2; ++bj) { const f32x4 v0 = acc[ai][bj][m][0], v1 = acc[ai][bj][m][1];
                        u32x4 w; w.x = cvt_pk_bf16(v0[0], v0[1]); w.y = cvt_pk_bf16(v0[2], v0[3]); w.z = cvt_pk_bf16(v1[0], v1[1]); w.w = cvt_pk_bf16(v1[2], v1[3]);
                        *(u32x4*)(rowp + bj * HALF) = w; } }
        } else if (u.prob == 2) {
            const int col0 = u.pn * BM + wc * 32 + 8 * fq;
            float* ob = col0 < 1024 ? outk + col0 : outv + (col0 - 1024);
#pragma unroll
            for (int ai = 0; ai < 2; ++ai)
#pragma unroll
                for (int m = 0; m < 4; ++m) { const int row = row0 + ai * HALF + m * 16;
#pragma unroll
                    for (int bj = 0; bj < 2; ++bj) { const f32x4 v0 = acc[ai][bj][m][0], v1 = acc[ai][bj][m][1];
                        float* op = ob + (size_t)row * 1024 + bj * HALF; *(f32x4*)op = v0; *(f32x4*)(op + 4) = v1;
                        u32x4 w; w.x = cvt_pk_bf16(v0[0], v0[1]); w.y = cvt_pk_bf16(v0[2], v0[3]); w.z = cvt_pk_bf16(v1[0], v1[1]); w.w = cvt_pk_bf16(v1[2], v1[3]);
                        *(u32x4*)(mkv + (size_t)row * 2048 + col0 + bj * HALF) = w; } }
        } else if (u.pn < 32) {
            const int col0 = u.pn * BM + wc * 32 + 8 * fq;
#pragma unroll
            for (int ai = 0; ai < 2; ++ai)
#pragma unroll
                for (int m = 0; m < 4; ++m) { bf16_t* rowp = zs + (size_t)(row0 + ai * HALF + m * 16) * ZS_LD + col0;
#pragma unroll
                    for (int bj = 0; bj < 2; ++bj) { const f32x4 v0 = acc[ai][bj][m][0], v1 = acc[ai][bj][m][1];
                        u32x4 w; w.x = cvt_pk_bf16(v0[0], v0[1]); w.y = cvt_pk_bf16(v0[2], v0[3]); w.z = cvt_pk_bf16(v1[0], v1[1]); w.w = cvt_pk_bf16(v1[2], v1[3]);
                        *(u32x4*)(rowp + bj * HALF) = w; } }
        } else {
            const int col0 = (u.pn - 32) * BM + wc * 32 + 8 * fq;
            f32x4 bv[2][2];
#pragma unroll
            for (int bj = 0; bj < 2; ++bj)
#pragma unroll
                for (int n = 0; n < 2; ++n) bv[bj][n] = *(const f32x4*)(bmerge + col0 + bj * HALF + 4 * n);
#pragma unroll
            for (int ai = 0; ai < 2; ++ai)
#pragma unroll
                for (int m = 0; m < 4; ++m) { bf16_t* rowp = gates + (size_t)(row0 + ai * HALF + m * 16) * G_LD + col0;
#pragma unroll
                    for (int bj = 0; bj < 2; ++bj) { f32x4 v0 = acc[ai][bj][m][0] + bv[bj][0], v1 = acc[ai][bj][m][1] + bv[bj][1];
#pragma unroll
                        for (int j = 0; j < 4; ++j) { v0[j] = sigmoidf_(v0[j]); v1[j] = sigmoidf_(v1[j]); }
                        u32x4 w; w.x = cvt_pk_bf16(v0[0], v0[1]); w.y = cvt_pk_bf16(v0[2], v0[3]); w.z = cvt_pk_bf16(v1[0], v1[1]); w.w = cvt_pk_bf16(v1[2], v1[3]);
                        *(u32x4*)(rowp + bj * HALF) = w; } }
        }
    }
};
struct EpiMix {
    static constexpr bool PERM = true, KHOOK = true;
    const bf16_t* gates; bf16_t* mixed;
    __device__ __forceinline__ void khook(f32x4 (&acc)[2][2][4][2], const Unit& u, int seg, int wr, int wc, int fr, int fq) const {
        const unsigned char* gb0 = (const unsigned char*)gates + ((size_t)(u.pm * BM + wr * 64) * G_LD + seg * DM + u.pn * BM + wc * 32) * 2;
        const unsigned lo = (unsigned)(fr * G_LD + 8 * fq) * 2u;
#pragma unroll
        for (int ai = 0; ai < 2; ++ai) {
            u32x4 ga[4][2], gb[4][2];
#pragma unroll
            for (int m = 0; m < 4; ++m)
#pragma unroll
                for (int bj = 0; bj < 2; ++bj) { const unsigned char* p = gb0 + (size_t)((ai * HALF + m * 16) * G_LD + bj * HALF) * 2; ga[m][bj] = *(const u32x4*)(p + lo); gb[m][bj] = *(const u32x4*)(p + DM * 2 + lo); }
#pragma unroll
            for (int m = 0; m < 4; ++m)
#pragma unroll
                for (int bj = 0; bj < 2; ++bj) { float a[8], b[8]; unpack8(ga[m][bj], a); unpack8(gb[m][bj], b);
#pragma unroll
                    for (int j = 0; j < 4; ++j) { acc[ai][bj][m][0][j] *= a[j] * __builtin_amdgcn_rcpf(fmaxf(b[j], 1e-30f)); acc[ai][bj][m][1][j] *= a[4 + j] * __builtin_amdgcn_rcpf(fmaxf(b[4 + j], 1e-30f)); } }
            __builtin_amdgcn_sched_barrier(0);
        }
    }
    __device__ __forceinline__ void operator()(const f32x4 (&acc)[2][2][4][2], const Unit& u, int wr, int wc, int fr, int fq) const {
        const int row0 = u.pm * BM + wr * 64 + fr, col0 = u.pn * BM + wc * 32 + 8 * fq;
#pragma unroll
        for (int ai = 0; ai < 2; ++ai)
#pragma unroll
            for (int m = 0; m < 4; ++m) { const size_t row = (size_t)(row0 + ai * HALF + m * 16);
#pragma unroll
                for (int bj = 0; bj < 2; ++bj) { float g[8]; unpack8(*(const u32x4*)(gates + row * G_LD + 2 * DM + col0 + bj * HALF), g);
                    const f32x4 v0 = acc[ai][bj][m][0], v1 = acc[ai][bj][m][1];
                    u32x4 w; w.x = cvt_pk_bf16(v0[0] * g[0], v0[1] * g[1]); w.y = cvt_pk_bf16(v0[2] * g[2], v0[3] * g[3]); w.z = cvt_pk_bf16(v1[0] * g[4], v1[1] * g[5]); w.w = cvt_pk_bf16(v1[2] * g[6], v1[3] * g[7]);
                    *(u32x4*)(mixed + row * DM + col0 + bj * HALF) = w; } }
    }
};
struct EpiX1 {
    static constexpr bool PERM = false, KHOOK = false;
    const float* xp; const float* xs; float* out;
    __device__ __forceinline__ void operator()(const f32x4 (&acc)[2][2][4][2], const Unit& u, int wr, int wc, int fr, int fq) const {
        const int row0 = u.pm * BM + wr * 64 + fr, col0 = u.pn * BM + wc * 32 + 4 * fq;
#pragma unroll
        for (int ai = 0; ai < 2; ++ai)
#pragma unroll
            for (int m = 0; m < 4; ++m) { const int row = row0 + ai * HALF + m * 16; const float* xr = (row < TP ? xp + (size_t)row * DM : xs + (size_t)(row - TP) * DM) + col0; float* orow = out + (size_t)row * DM + col0;
#pragma unroll
                for (int bj = 0; bj < 2; ++bj)
#pragma unroll
                    for (int n = 0; n < 2; ++n) *(f32x4*)(orow + bj * HALF + n * 16) = *(const f32x4*)(xr + bj * HALF + n * 16) + acc[ai][bj][m][n]; }
    }
};
struct EpiGU {
    static constexpr bool PERM = true, KHOOK = false;
    bf16_t* h;
    __device__ __forceinline__ void operator()(const f32x4 (&acc)[2][2][4][2], const Unit& u, int wr, int wc, int fr, int fq) const {
        const int row0 = u.pm * BM + wr * 64 + fr, col0 = u.pn * HALF + wc * 32 + 8 * fq;
#pragma unroll
        for (int ai = 0; ai < 2; ++ai)
#pragma unroll
            for (int m = 0; m < 4; ++m) { float o[8];
#pragma unroll
                for (int n = 0; n < 2; ++n)
#pragma unroll
                    for (int j = 0; j < 4; ++j) { const float gt = acc[ai][0][m][n][j], up = acc[ai][1][m][n][j]; o[4 * n + j] = gt * sigmoidf_(gt) * up; }
                u32x4 w; w.x = cvt_pk_bf16(o[0], o[1]); w.y = cvt_pk_bf16(o[2], o[3]); w.z = cvt_pk_bf16(o[4], o[5]); w.w = cvt_pk_bf16(o[6], o[7]);
                *(u32x4*)(h + (size_t)(row0 + ai * HALF + m * 16) * DFF + col0) = w; }
    }
};
struct EpiDown {
    static constexpr bool PERM = false, KHOOK = false;
    float* out;
    __device__ __forceinline__ void operator()(const f32x4 (&acc)[2][2][4][2], const Unit& u, int wr, int wc, int fr, int fq) const {
        const int row0 = u.pm * BM + wr * 64 + fr, col0 = u.pn * BM + wc * 32 + 4 * fq;
#pragma unroll
        for (int ai = 0; ai < 2; ++ai)
#pragma unroll
            for (int m = 0; m < 4; ++m) { float* orow = out + (size_t)(row0 + ai * HALF + m * 16) * DM + col0;
#pragma unroll
                for (int bj = 0; bj < 2; ++bj)
#pragma unroll
                    for (int n = 0; n < 2; ++n) { f32x4* p = (f32x4*)(orow + bj * HALF + n * 16); *p = *p + acc[ai][bj][m][n]; } }
    }
};
}

__device__ __forceinline__ v4u ldg16(const unsigned char* ubase, unsigned off) { return *(const v4u*)(ubase + off); }
__device__ __forceinline__ void stg16(unsigned char* ubase, unsigned off, v4u v) { *(v4u*)(ubase + off) = v; }
__device__ __forceinline__ void win_map(int drow, int& src, int& nvalid, float& scale) {
    nvalid = 32; scale = 1.f;
    if (drow < 2048) { src = drow; if (drow < 1024) scale = 0.0625f; }
    else if (drow < NMAIN) { src = drow + 2064; if (drow >= ZXQ && drow < ZS_LD) scale = 0.0625f; }
    else if (drow < WA_ROW) src = drow - 18432;
    else { src = 4096; nvalid = 16; }
}
__device__ __forceinline__ void ph0_prologue(Frame& F) {
    int tid_ = threadIdx.x; asm volatile("" : "+v"(tid_)); const int tid = tid_, lane = tid & 63; (void)lane;
    LAS float* scr = (LAS float*)(F.lds + F.wave * 16384);
    const int gw = F.vcu * NWAVES + F.wave, NGW = F.G * NWAVES;
    bf16* Wint = (bf16*)(F.ws + WS_RA); bf16* Wbr = (bf16*)(F.ws + WS_WBR); bf16* Wout = (bf16*)(F.ws + WS_WOUT); bf16* Wkv = (bf16*)(F.ws + WS_WKV);
    constexpr int I_IN = 705 * 64, I_GLA = 128 * 32, I_CV = 128 * 16, I_XA = 128 * 16, I_OUT = 128 * 64, I_KV = 64 * 64;
    constexpr int NITEMS = I_IN + I_GLA + I_CV + I_XA + I_OUT + I_KV;
    for (int it = gw; it < NITEMS; it += NGW) {
        int r = it;
        if (r < I_IN) { const int nb = r >> 6, kb = r & 63; int src, nv; float sc; win_map(nb * 32, src, nv, sc);
            tr_item(F.in[I_WIN] + (size_t)(kb * 64) * IN_COLS + src, IN_COLS, nv, sc, Wint + (size_t)(nb * 32) * DM + kb * 64, DM, scr, lane); continue; } r -= I_IN;
        if (r < I_GLA) { const int nb = r >> 5, kb = r & 31;
            tr_item(F.in[I_WGLAO] + (size_t)(kb * 64) * DM + nb * 32, DM, 32, 1.f, Wbr + (size_t)(nb * 32) * DM + kb * 64, DM, scr, lane); continue; } r -= I_GLA;
        if (r < I_CV) { const int nb = r >> 4, kb = r & 15;
            tr_item(F.in[I_WCONVO] + (size_t)(kb * 64) * DM + nb * 32, DM, 32, 1.f, Wbr + (size_t)(nb * 32) * DM + 2048 + kb * 64, DM, scr, lane); continue; } r -= I_CV;
        if (r < I_XA) { const int nb = r >> 4, kb = r & 15;
            tr_item(F.in[I_WXAO] + (size_t)(kb * 64) * DM + nb * 32, DM, 32, 1.f, Wbr + (size_t)(nb * 32) * DM + 3072 + kb * 64, DM, scr, lane); continue; } r -= I_XA;
        if (r < I_OUT) { const int nb = r >> 6, kb = r & 63;
            tr_item(F.in[I_WOUT] + (size_t)(kb * 64) * DM + nb * 32, DM, 32, 1.f, Wout + (size_t)(nb * 32) * DM + kb * 64, DM, scr, lane); continue; } r -= I_OUT;
        { const int nb = r >> 6, kb = r & 63;
            tr_item(F.in[I_WMEMKV] + (size_t)(kb * 64) * 2048 + nb * 32, 2048, 32, 1.f, Wkv + (size_t)(nb * 32) * DM + kb * 64, DM, scr, lane); }
    }
    bf16* xn = (bf16*)((unsigned char*)F.out + OY_XN); bf16* memn = (bf16*)(F.ws + WS_MEMN);
    for (int m = gw; m < T + 512; m += NGW) {
        if (m < T) rms_row_to_bf16(xrow_ptr(F, m), F.in[I_GMIX], xn + (size_t)m * DM, lane);
        else rms_row_to_bf16(F.in[I_MEMP] + (size_t)(m - T) * DM, F.in[I_GMEM], memn + (size_t)(m - T) * DM, lane);
    }
    bf16* mkv = (bf16*)(F.ws + WS_MKV);
    const int gt = F.vcu * NTHR + tid, NGT = F.G * NTHR;
    for (int i = gt; i < 32 * 256 * 256; i += NGT) {
        const int row = i >> 8, c4 = i & 255;
        const f32x4 v = *((const f32x4*)(F.in[I_CMK]) + (size_t)row * 256 + c4);
        v2u w; w.x = pk2(v.x, v.y); w.y = pk2(v.z, v.w);
        *(v2u*)(mkv + (size_t)(512 + row) * 2048 + c4 * 4) = w;
    }
    bf16* mvT = (bf16*)(F.ws + WS_MVT);
    for (int it = gw; it < 32 * 128; it += NGW) { const int b = it >> 7, nb = (it >> 2) & 31, kb = it & 3;
        tr_item(F.in[I_CMV] + (size_t)b * 262144 + (size_t)(kb * 64) * 1024 + nb * 32, 1024, 32, 1.f, mvT + (size_t)(2 + b) * 262144 + (size_t)(nb * 32) * 256 + kb * 64, 256, scr, lane); }
}

__device__ __forceinline__ void ph_g0(Frame& F) {
    int tid_ = threadIdx.x; asm volatile("" : "+v"(tid_)); const int tid = tid_, lane = tid & 63; (void)lane;
    bf16* zs = (bf16*)(F.ws + WS_ZS); const float* alr = (const float*)(F.ws + WS_ALR); float* Aout = (float*)(F.ws + WS_AOUT); bf16* kinT = (bf16*)(F.ws + WS_KINT);
    LAS float* alr_s = (LAS float*)F.lds; LAS float* tot = alr_s + 64 * 16;
    const int c = tid & 127, tg = tid >> 7;
    for (int unit = F.vcu; unit < NCHK * 8; unit += F.G) {
        const int ci = unit >> 3, ch = (unit & 7) * 128 + c;
        __syncthreads();
        if (tid < 256) *(LAS f32x4*)(alr_s + tid * 4) = *(const f32x4*)(alr + (size_t)ci * 64 * RANK + tid * 4);
        float w[16];
#pragma unroll
        for (int r = 0; r < 16; ++r) w[r] = F.in[I_WA2][r * GK + ch];
        const float ba = F.in[I_BA][ch];
        __syncthreads();
        float Bl[16]; float run = 0.f;
#pragma unroll
        for (int tt = 0; tt < 16; ++tt) { const LAS float* ar = alr_s + (tg * 16 + tt) * 16; float x = ba;
#pragma unroll
            for (int r = 0; r < 16; ++r) x += ar[r] * w[r];
            const float ls = fminf(x, 0.f) - __logf(1.f + __expf(-fabsf(x)));
            run += ls * 0.0625f; Bl[tt] = run; }
        tot[tg * 128 + c] = run;
        __syncthreads();
        float off = 0.f, blast = 0.f;
#pragma unroll
        for (int g = 0; g < 4; ++g) { const float tv = tot[g * 128 + c]; blast += tv; if (g < tg) off += tv; }
        bf16 kt[16], qv[16], kv[16];
        bf16* qp0 = zs + ((size_t)ci * 64 + tg * 16) * ZS_LD + ZQ + ch; bf16* kp0 = qp0 + (ZK - ZQ);
#pragma unroll
        for (int tt = 0; tt < 16; ++tt) { qv[tt] = qp0[(size_t)tt * ZS_LD]; kv[tt] = kp0[(size_t)tt * ZS_LD]; }
#pragma unroll
        for (int tt = 0; tt < 16; ++tt) { const float B = Bl[tt] + off;
            kt[tt] = f2bf1(bf1(kv[tt]) * __expf(-B)); qv[tt] = f2bf1(bf1(qv[tt]) * __expf(B)); }
#pragma unroll
        for (int tt = 0; tt < 16; ++tt) { qp0[(size_t)tt * ZS_LD] = qv[tt]; kp0[(size_t)tt * ZS_LD] = kt[tt]; }
        { v4u w0, w1; w0.x = kt[0] | ((unsigned)kt[1] << 16); w0.y = kt[2] | ((unsigned)kt[3] << 16); w0.z = kt[4] | ((unsigned)kt[5] << 16); w0.w = kt[6] | ((unsigned)kt[7] << 16);
          w1.x = kt[8] | ((unsigned)kt[9] << 16); w1.y = kt[10] | ((unsigned)kt[11] << 16); w1.z = kt[12] | ((unsigned)kt[13] << 16); w1.w = kt[14] | ((unsigned)kt[15] << 16);
          bf16* ktp = kinT + (size_t)ch * T + ci * 64 + tg * 16; *(v4u*)ktp = w0; *(v4u*)(ktp + 8) = w1; }
        if (tg == 0) Aout[(size_t)ci * GK + ch] = __expf(blast);
    }
}
__device__ __forceinline__ void ph_conv(Frame& F) {
    int tid_ = threadIdx.x; asm volatile("" : "+v"(tid_)); const int tid = tid_, lane = tid & 63; (void)lane;
    const bf16* zs = (const bf16*)(F.ws + WS_ZS); bf16* br = (bf16*)((unsigned char*)F.out + OY_BR);
    const int gt = F.vcu * NTHR + tid, NGT = F.G * NTHR;
    for (int item = gt; item < T * 128; item += NGT) {
        const int row = item >> 7, c8 = (item & 127) * 8;
        int t, Tlen, sb; if (row < TP) { t = row & (SEQP - 1); Tlen = SEQP; sb = -1; } else { t = (row - TP) & 63; Tlen = 64; sb = (row - TP) >> 6; }
        float u[3][8];
#pragma unroll
        for (int d = 0; d < 3; ++d) {
            if (t - d >= 0) { float a[8], b[8]; unpack8(*(const v4u*)(zs + (size_t)(row - d) * ZS_LD + ZCC + c8), a); unpack8(*(const v4u*)(zs + (size_t)(row - d) * ZS_LD + ZCH + c8), b);
#pragma unroll
                for (int j = 0; j < 8; ++j) u[d][j] = a[j] * b[j]; }
            else if (sb >= 0) { const float* bp = F.in[I_CCONV] + ((size_t)sb * 2 + (t - d + 2)) * CW + c8;
#pragma unroll
                for (int j = 0; j < 8; ++j) u[d][j] = bp[j]; }
            else {
#pragma unroll
                for (int j = 0; j < 8; ++j) u[d][j] = 0.f; }
        }
        float cb[8], o[8]; unpack8(*(const v4u*)(zs + (size_t)row * ZS_LD + ZCB + c8), cb);
        const float* wc = F.in[I_WCONV] + c8;
#pragma unroll
        for (int j = 0; j < 8; ++j) o[j] = cb[j] * (u[2][j] * wc[j] + u[1][j] * wc[CW + j] + u[0][j] * wc[2 * CW + j]);
        *(v4u*)(br + (size_t)row * DM + 2048 + c8) = pack8(o);
        if (t >= Tlen - 2) { float* ob = (sb < 0) ? F.out + O_CCP + ((size_t)(row >> 13) * 2 + (t - (Tlen - 2))) * CW + c8 : F.out + O_CCS + ((size_t)sb * 2 + (t - (Tlen - 2))) * CW + c8;
#pragma unroll
            for (int j = 0; j < 8; ++j) ob[j] = u[0][j]; }
    }
}
typedef short bf16x8 __attribute__((ext_vector_type(8)));
__device__ __forceinline__ bf16x8 ldfrag(const unsigned char* ubase, unsigned off) { return *(const bf16x8*)(ubase + off); }
__device__ __forceinline__ void ph1_alr(Frame& F, const bf16* xn, const bf16* WaT) {
    int tid_ = threadIdx.x; asm volatile("" : "+v"(tid_)); const int lane = tid_ & 63, fr = lane & 15, fq = lane >> 4;
    const int gw = F.vcu * NWAVES + F.wave, NGW = F.G * NWAVES; float* alr = (float*)(F.ws + WS_ALR);
    const unsigned xrow = (unsigned)(fr * DM + 8 * fq) * 2u;
    for (int it = gw; it < T / 16; it += NGW) {
        const unsigned char* xb = (const unsigned char*)xn + (size_t)it * 16 * DM * 2; const unsigned char* wb = (const unsigned char*)WaT;
        f32x4 acc = (f32x4){0.f, 0.f, 0.f, 0.f};
#pragma unroll 1
        for (int k8 = 0; k8 < 16; ++k8) { bf16x8 fx[8], fw[8];
#pragma unroll
            for (int j = 0; j < 8; ++j) { fx[j] = ldfrag(xb + (k8 * 8 + j) * 64, xrow); fw[j] = ldfrag(wb + (k8 * 8 + j) * 64, xrow); }
#pragma unroll
            for (int j = 0; j < 8; ++j) acc = __builtin_amdgcn_mfma_f32_16x16x32_bf16(fw[j], fx[j], acc, 0, 0, 0); }
        *(f32x4*)(alr + (size_t)(it * 16 + fr) * RANK + 4 * fq) = acc;
    }
}
__device__ __forceinline__ void ph_g1(Frame& F) {
    int tid_ = threadIdx.x; asm volatile("" : "+v"(tid_)); const int tid = tid_, lane = tid & 63, fr = lane & 15, fq = lane >> 4, w = F.wave;
    const unsigned lrow = (unsigned)(fr * T + 8 * fq) * 2u;
    for (int unit = F.vcu; unit < NCHK * NH; unit += F.G) {
        const int ci = unit >> 2, h = unit & 3;
        const unsigned char* vb = F.ws + WS_VT + ((size_t)(h * DV + 64 * w) * T + ci * 64) * 2;
        const unsigned char* kb = F.ws + WS_KINT + ((size_t)(h * DK) * T + ci * 64) * 2;
        unsigned char* slot = (unsigned char*)slot_ptr(F, ci, h);
        const float* Ap = (const float*)(F.ws + WS_AOUT) + (size_t)ci * GK + h * DK;
        bf16x8 fv[4][2];
#pragma unroll
        for (int n = 0; n < 4; ++n)
#pragma unroll
            for (int ks = 0; ks < 2; ++ks) fv[n][ks] = ldfrag(vb + (size_t)(16 * n) * T * 2 + ks * 64, lrow);
#pragma unroll 1
        for (int qd = 0; qd < 4; ++qd) {
            bf16x8 fk[4][2]; f32x4 acc[4][4];
#pragma unroll
            for (int c = 0; c < 4; ++c)
#pragma unroll
                for (int ks = 0; ks < 2; ++ks) fk[c][ks] = ldfrag(kb + (size_t)(64 * qd + 16 * c) * T * 2 + ks * 64, lrow);
#pragma unroll
            for (int n = 0; n < 4; ++n)
#pragma unroll
                for (int c = 0; c < 4; ++c) { acc[n][c] = (f32x4){0.f, 0.f, 0.f, 0.f};
#pragma unroll
                    for (int ks = 0; ks < 2; ++ks) acc[n][c] = __builtin_amdgcn_mfma_f32_16x16x32_bf16(fk[c][ks], fv[n][ks], acc[n][c], 0, 0, 0); }
#pragma unroll
            for (int c = 0; c < 4; ++c) { const int dk0 = 64 * qd + 16 * c + 4 * fq; const f32x4 A = *(const f32x4*)(Ap + dk0);
#pragma unroll
                for (int n = 0; n < 4; ++n) { const f32x4 v = acc[n][c] * A; v2u o; o.x = pk2(v[0], v[1]); o.y = pk2(v[2], v[3]);
                    *(v2u*)(slot + ((size_t)(64 * w + 16 * n + fr) * DK + dk0) * 2) = o; } }
        }
    }
}
__device__ __forceinline__ void ph_xattn(Frame& F) {
    int tid_ = threadIdx.x; asm volatile("" : "+v"(tid_)); const int tid = tid_, lane = tid & 63, fr = lane & 15, fq = lane >> 4, w = F.wave;
    const unsigned zrow = (unsigned)(fr * ZS_LD + 8 * fq) * 2u, krow = (unsigned)(fr * 2048 + 8 * fq) * 2u, vrow = (unsigned)(fr * 256 + 4 * fq) * 2u;
    for (int pu = F.vcu; pu < NCHK * NH / 2; pu += F.G) {
        const int unit = 2 * pu + (w >> 2), ci = unit >> 2, h = unit & 3; int seq, cis; chunk_seq(ci, seq, cis);
        const int t0 = ci * 64 + 16 * (w & 3);
        const unsigned char* qb = F.ws + WS_ZS + ((size_t)t0 * ZS_LD + ZXQ + h * XDH) * 2;
        const unsigned char* kb = F.ws + WS_MKV + ((size_t)seq * 256 * 2048 + h * XDH) * 2;
        const unsigned char* vb = F.ws + WS_MVT + (size_t)(seq * NH + h) * 65536 * 2;
        bf16x8 fqx[8];
#pragma unroll
        for (int ks = 0; ks < 8; ++ks) fqx[ks] = ldfrag(qb + ks * 64, zrow);
        f32x4 sc[16];
#pragma unroll
        for (int c = 0; c < 16; ++c) { sc[c] = (f32x4){0.f, 0.f, 0.f, 0.f};
            bf16x8 fk[8];
#pragma unroll
            for (int ks = 0; ks < 8; ++ks) fk[ks] = ldfrag(kb + (size_t)(16 * c) * 4096 + ks * 64, krow);
#pragma unroll
            for (int ks = 0; ks < 8; ++ks) sc[c] = __builtin_amdgcn_mfma_f32_16x16x32_bf16(fk[ks], fqx[ks], sc[c], 0, 0, 0); }
        float mx = -3.0e38f;
#pragma unroll
        for (int c = 0; c < 16; ++c) mx = fmaxf(mx, fmaxf(fmaxf(sc[c][0], sc[c][1]), fmaxf(sc[c][2], sc[c][3])));
        mx = fmaxf(mx, __shfl_xor(mx, 16)); mx = fmaxf(mx, __shfl_xor(mx, 32));
        float sm = 0.f;
#pragma unroll
        for (int c = 0; c < 16; ++c)
#pragma unroll
            for (int i = 0; i < 4; ++i) { const float e = __expf(sc[c][i] - mx); sc[c][i] = e; sm += e; }
        sm += __shfl_xor(sm, 16); sm += __shfl_xor(sm, 32);
        const float inv = 1.f / sm;
        bf16x8 pb[8];
#pragma unroll
        for (int k2 = 0; k2 < 8; ++k2) { v4u u; u.x = pk2(sc[2 * k2][0] * inv, sc[2 * k2][1] * inv); u.y = pk2(sc[2 * k2][2] * inv, sc[2 * k2][3] * inv);
            u.z = pk2(sc[2 * k2 + 1][0] * inv, sc[2 * k2 + 1][1] * inv); u.w = pk2(sc[2 * k2 + 1][2] * inv, sc[2 * k2 + 1][3] * inv); pb[k2] = __builtin_bit_cast(bf16x8, u); }
        unsigned char* ob = (unsigned char*)F.out + OY_BR + ((size_t)(t0 + fr) * DM + 3072 + h * XDH + 4 * fq) * 2;
#pragma unroll 4
        for (int c = 0; c < 16; ++c) {
            f32x4 oc = (f32x4){0.f, 0.f, 0.f, 0.f};
            v2u va[8], vc[8];
#pragma unroll
            for (int k2 = 0; k2 < 8; ++k2) { const unsigned char* pp = vb + (size_t)(16 * c) * 512 + k2 * 64; va[k2] = *(const v2u*)(pp + vrow); vc[k2] = *(const v2u*)(pp + 32 + vrow); }
#pragma unroll
            for (int k2 = 0; k2 < 8; ++k2) { v4u u; u.x = va[k2].x; u.y = va[k2].y; u.z = vc[k2].x; u.w = vc[k2].y;
                oc = __builtin_amdgcn_mfma_f32_16x16x32_bf16(__builtin_bit_cast(bf16x8, u), pb[k2], oc, 0, 0, 0); }
            v2u ow; ow.x = pk2(oc[0], oc[1]); ow.y = pk2(oc[2], oc[3]); *(v2u*)(ob + c * 32) = ow;
        }
    }
}
__device__ __forceinline__ void ph_g2(Frame& F) {
    int tid_ = threadIdx.x; asm volatile("" : "+v"(tid_)); const int tid = tid_;
    const float* Aout = (const float*)(F.ws + WS_AOUT);
    const int gt = F.vcu * NTHR + tid, NGT = F.G * NTHR;
    for (int item = gt; item < 2 * NH * DV * 32; item += NGT) {
        const int dk8 = item & 31, dv = (item >> 5) & 511, h = (item >> 14) & 3, seq = item >> 16;
        float S[8];
#pragma unroll
        for (int e = 0; e < 8; ++e) S[e] = 0.f;
        unsigned char* sb0 = F.ws + (seq ? WS_DS1 : WS_DS0) + ((size_t)h << 18) + ((size_t)dv * DK + dk8 * 8) * 2;
        const float* ap0 = Aout + (size_t)(seq * 128) * GK + h * DK + dk8 * 8;
#pragma unroll 1
        for (int c0 = 0; c0 < 128; c0 += 8) {
            v4u dd[8]; f32x4 a0[8], a1[8];
#pragma unroll
            for (int j = 0; j < 8; ++j) { dd[j] = *(const v4u*)(sb0 + ((size_t)(c0 + j) << 20)); const float* ap = ap0 + (size_t)(c0 + j) * GK; a0[j] = *(const f32x4*)ap; a1[j] = *(const f32x4*)(ap + 4); }
#pragma unroll
            for (int j = 0; j < 8; ++j) { float d[8]; unpack8(dd[j], d); *(v4u*)(sb0 + ((size_t)(c0 + j) << 20)) = pack8(S);
                S[0] = a0[j].x * S[0] + d[0]; S[1] = a0[j].y * S[1] + d[1]; S[2] = a0[j].z * S[2] + d[2]; S[3] = a0[j].w * S[3] + d[3];
                S[4] = a1[j].x * S[4] + d[4]; S[5] = a1[j].y * S[5] + d[5]; S[6] = a1[j].z * S[6] + d[6]; S[7] = a1[j].w * S[7] + d[7]; }
        }
        float* op = F.out + O_SGP + ((size_t)((seq * NH + h) * DK + dk8 * 8)) * DV + dv;
#pragma unroll
        for (int e = 0; e < 8; ++e) op[(size_t)e * DV] = S[e];
    }
    LAS float* t_s = (LAS float*)F.lds;
    for (int unit = F.vcu; unit < 32 * NH * 8; unit += F.G) {
        const int vb = unit & 7, h = (unit >> 3) & 3, b = unit >> 5; const int ci = NCHK_P + b;
        const size_t so = ((size_t)((b * NH + h) * DK)) * DV + vb * 64;
        const float* s0p = F.in[I_SGLA] + so; float* outp = F.out + O_SGS + so;
        bf16* slot = slot_ptr(F, ci, h) + (size_t)(vb * 64) * DK;
        const float* ap = Aout + (size_t)ci * GK + h * DK;
        __syncthreads();
#pragma unroll
        for (int q = 0; q < 8; ++q) { const int idx = tid + q * NTHR, dk = idx >> 4, d4 = (idx & 15) * 4;
            const f32x4 v = *(const f32x4*)(s0p + (size_t)dk * DV + d4);
            t_s[dk * 65 + d4] = v.x; t_s[dk * 65 + d4 + 1] = v.y; t_s[dk * 65 + d4 + 2] = v.z; t_s[dk * 65 + d4 + 3] = v.w; }
        __syncthreads();
#pragma unroll
        for (int q = 0; q < 4; ++q) { const int idx = tid + q * NTHR, dv = idx >> 5, dk8 = idx & 31;
            v4u* sp = (v4u*)(slot + (size_t)dv * DK + dk8 * 8); float d[8], s[8]; unpack8(*sp, d);
#pragma unroll
            for (int e = 0; e < 8; ++e) s[e] = t_s[(dk8 * 8 + e) * 65 + dv];
            *sp = pack8(s);
            const f32x4 a0 = *(const f32x4*)(ap + dk8 * 8), a1 = *(const f32x4*)(ap + dk8 * 8 + 4); const float a[8] = {a0.x, a0.y, a0.z, a0.w, a1.x, a1.y, a1.z, a1.w};
#pragma unroll
            for (int e = 0; e < 8; ++e) t_s[(dk8 * 8 + e) * 65 + dv] = a[e] * s[e] + d[e]; }
        __syncthreads();
#pragma unroll
        for (int q = 0; q < 8; ++q) { const int idx = tid + q * NTHR, dk = idx >> 4, d4 = (idx & 15) * 4;
            *(f32x4*)(outp + (size_t)dk * DV + d4) = (f32x4){t_s[dk * 65 + d4], t_s[dk * 65 + d4 + 1], t_s[dk * 65 + d4 + 2], t_s[dk * 65 + d4 + 3]}; }
    }
}
__device__ __forceinline__ void ph_g3(Frame& F) {
    int tid_ = threadIdx.x; asm volatile("" : "+v"(tid_)); const int tid = tid_, lane = tid & 63, fr = lane & 15, fq = lane >> 4, w = F.wave;
    constexpr int PP = 144;
    LAS unsigned char* P_s = F.lds; LAS float* red = (LAS float*)(F.lds + 64 * PP);
    const unsigned zrow = (unsigned)(fr * ZS_LD + 8 * fq) * 2u;
    const unsigned srow = (unsigned)(fr * DK + 8 * fq) * 2u;
    const unsigned vrow = (unsigned)(fr * T + 8 * fq) * 2u;
    for (int unit = F.vcu; unit < NCHK * NH; unit += F.G) {
        const int ci = unit >> 2, h = unit & 3;
        const unsigned char* zc = F.ws + WS_ZS + (size_t)ci * 64 * ZS_LD * 2;
        const unsigned char* qb = zc + (ZQ + h * DK) * 2; const unsigned char* kb = zc + (ZK + h * DK) * 2;
        __syncthreads();
        {
            const int a = w >> 1; f32x4 pc[2] = {(f32x4){0.f, 0.f, 0.f, 0.f}, (f32x4){0.f, 0.f, 0.f, 0.f}};
#pragma unroll
            for (int ks = 0; ks < 8; ++ks) { const bf16x8 fqn = ldfrag(qb + (size_t)(16 * a) * ZS_LD * 2 + ks * 64, zrow);
#pragma unroll
                for (int c2 = 0; c2 < 2; ++c2) { const bf16x8 fkn = ldfrag(kb + (size_t)(16 * (2 * (w & 1) + c2)) * ZS_LD * 2 + ks * 64, zrow);
                    pc[c2] = __builtin_amdgcn_mfma_f32_16x16x32_bf16(fkn, fqn, pc[c2], 0, 0, 0); } }
#pragma unroll
            for (int c2 = 0; c2 < 2; ++c2) { const int t = 16 * a + fr, s0 = 16 * (2 * (w & 1) + c2) + 4 * fq; float pv[4];
#pragma unroll
                for (int i = 0; i < 4; ++i) pv[i] = (s0 + i <= t) ? pc[c2][i] : 0.f;
                v2u o; o.x = pk2(pv[0], pv[1]); o.y = pk2(pv[2], pv[3]); *(LAS v2u*)(P_s + t * PP + s0 * 2) = o; }
        }
        __syncthreads();
        f32x4 acc[4][4];
#pragma unroll
        for (int n = 0; n < 4; ++n)
#pragma unroll
            for (int a = 0; a < 4; ++a) acc[n][a] = (f32x4){0.f, 0.f, 0.f, 0.f};
        const unsigned char* sb = (const unsigned char*)slot_ptr(F, ci, h) + (size_t)(64 * w) * DK * 2;
#pragma unroll 2
        for (int ks = 0; ks < 8; ++ks) {
            bf16x8 fs[4], fqn[4];
#pragma unroll
            for (int n = 0; n < 4; ++n) fs[n] = ldfrag(sb + (size_t)(16 * n) * DK * 2 + ks * 64, srow);
#pragma unroll
            for (int a = 0; a < 4; ++a) fqn[a] = ldfrag(qb + (size_t)(16 * a) * ZS_LD * 2 + ks * 64, zrow);
#pragma unroll
            for (int n = 0; n < 4; ++n)
#pragma unroll
                for (int a = 0; a < 4; ++a) acc[n][a] = __builtin_amdgcn_mfma_f32_16x16x32_bf16(fs[n], fqn[a], acc[n][a], 0, 0, 0);
        }
        const unsigned char* vb = F.ws + WS_VT + ((size_t)(h * DV + 64 * w) * T + ci * 64) * 2;
#pragma unroll
        for (int ks = 0; ks < 2; ++ks) {
            bf16x8 fv[4], fp[4];
#pragma unroll
            for (int n = 0; n < 4; ++n) fv[n] = ldfrag(vb + (size_t)(16 * n) * T * 2 + ks * 64, vrow);
#pragma unroll
            for (int a = 0; a < 4; ++a) fp[a] = *(const LAS bf16x8*)(P_s + (16 * a + fr) * PP + ks * 64 + fq * 16);
#pragma unroll
            for (int n = 0; n < 4; ++n)
#pragma unroll
                for (int a = 0; a < 4; ++a) acc[n][a] = __builtin_amdgcn_mfma_f32_16x16x32_bf16(fv[n], fp[a], acc[n][a], 0, 0, 0);
        }
#pragma unroll
        for (int a = 0; a < 4; ++a) { float ss = 0.f;
#pragma unroll
            for (int n = 0; n < 4; ++n) ss += (acc[n][a][0] * acc[n][a][0] + acc[n][a][1] * acc[n][a][1]) + (acc[n][a][2] * acc[n][a][2] + acc[n][a][3] * acc[n][a][3]);
            ss += __shfl_xor(ss, 16); ss += __shfl_xor(ss, 32);
            if (fq == 0) red[(16 * a + fr) * 8 + w] = ss; }
        __syncthreads();
        const unsigned char* rb = zc + (ZR + h * DV + 64 * w) * 2; unsigned char* bb = (unsigned char*)F.out + OY_BR + ((size_t)ci * 64 * DM + h * DV + 64 * w) * 2;
#pragma unroll
        for (int a = 0; a < 4; ++a) { const int t = 16 * a + fr; const LAS f32x4* rp = (const LAS f32x4*)(red + t * 8); const f32x4 r0 = rp[0], r1 = rp[1];
            const float rstd = rsqrtf(((r0.x + r0.y) + (r0.z + r0.w) + (r1.x + r1.y) + (r1.z + r1.w)) * (1.f / DV) + EPS);
#pragma unroll
            for (int n = 0; n < 4; ++n) { const int dvl = 16 * n + 4 * fq; const f32x4 gg = *(const f32x4*)(F.in[I_GGLA] + 64 * w + dvl);
                const v2u rw = *(const v2u*)(rb + (size_t)t * ZS_LD * 2 + dvl * 2); const float rr[4] = {bf_lo(rw.x), bf_hi(rw.x), bf_lo(rw.y), bf_hi(rw.y)}; float o[4];
#pragma unroll
                for (int i = 0; i < 4; ++i) o[i] = acc[n][a][i] * rstd * gg[i] * (rr[i] * sigmoidf_(rr[i]));
                v2u ow; ow.x = pk2(o[0], o[1]); ow.y = pk2(o[2], o[3]); *(v2u*)(bb + (size_t)t * DM * 2 + dvl * 2) = ow; } }
    }
}
constexpr int CW_CVT_NEXT = 8192, CW_ARRIVE6 = 8256, CW_ARRIVE7 = 8320;
constexpr int I_GU = (NGU_T / 32) * 64, I_DN = 128 * 172, N_FFN_ITEMS = I_GU + I_DN;
__device__ __forceinline__ void ffn_item(Frame& F, int r, LAS float* scr, int lane) {
    bf16* Wgu = (bf16*)(F.ws + WS_RA); bf16* Wdn = (bf16*)(F.ws + WS_WDN);
    if (r < I_GU) { const int nb = r >> 6, kb = r & 63, drow = nb * 32, tl = drow >> 8, w = drow & 255;
        const float* W = (w < 128) ? F.in[I_WFG] : F.in[I_WFU]; const int src = tl * 128 + (w & 127);
        tr_item(W + (size_t)(kb * 64) * DFF + src, DFF, 32, 1.f, Wgu + (size_t)drow * DM + kb * 64, DM, scr, lane); return; }
    r -= I_GU;
    { const int nb = r / 172, kb = r % 172;
        tr_item(F.in[I_WFD] + (size_t)(kb * 64) * DM + nb * 32, DM, 32, 1.f, Wdn + (size_t)(nb * 32) * DFF + kb * 64, DFF, scr, lane); }
}
__device__ __forceinline__ void ffn_steal(Frame& F, unsigned* arrive) {
    int tid_ = threadIdx.x; asm volatile("" : "+v"(tid_)); const int tid = tid_, lane = tid & 63;
    LAS float* scr = (LAS float*)(F.lds + F.wave * 16384);
    unsigned* next = (unsigned*)(F.ws + WS_CTL) + CW_CVT_NEXT;
    if (arrive) { __syncthreads(); if (tid == 0) __hip_atomic_fetch_add(arrive, 1u, __ATOMIC_RELAXED, __HIP_MEMORY_SCOPE_AGENT); }
    for (;;) {
        if (arrive && (unsigned)__builtin_amdgcn_readfirstlane(__hip_atomic_load(arrive, __ATOMIC_RELAXED, __HIP_MEMORY_SCOPE_AGENT)) >= (unsigned)F.G) break;
        unsigned it = 0; if (lane == 0) it = __hip_atomic_fetch_add(next, 1u, __ATOMIC_RELAXED, __HIP_MEMORY_SCOPE_AGENT);
        it = (unsigned)__builtin_amdgcn_readfirstlane(it);
        if (it >= (unsigned)N_FFN_ITEMS) break;
        ffn_item(F, (int)it, scr, lane);
    }
}
__device__ __forceinline__ void ph8_hn_ffnw(Frame& F) {
    int tid_ = threadIdx.x; asm volatile("" : "+v"(tid_)); const int tid = tid_, lane = tid & 63; (void)tid;
    LAS float* scr = (LAS float*)(F.lds + F.wave * 16384);
    const int gw = F.vcu * NWAVES + F.wave, NGW = F.G * NWAVES; bf16* hn = (bf16*)(F.ws + WS_HN);
    for (int it = gw; it < N_FFN_ITEMS; it += NGW) ffn_item(F, it, scr, lane);
    for (int m = gw; m < T; m += NGW) rms_row_to_bf16(F.out + (size_t)m * DM, F.in[I_GFFN], hn + (size_t)m * DM, lane);
}
__device__ __forceinline__ void ph11_final(Frame& F) {
    int tid_ = threadIdx.x; asm volatile("" : "+v"(tid_)); const int tid = tid_, lane = tid & 63; (void)lane;
    const int gw = F.vcu * NWAVES + F.wave, NGW = F.G * NWAVES;
    for (int m = gw; m < T; m += NGW) {
        f32x4* xr = (f32x4*)(F.out + (size_t)m * DM) + lane; const f32x4* gr = (const f32x4*)F.in[I_GFINAL] + lane;
        f32x4 v[16]; float s = 0.f;
#pragma unroll
        for (int j = 0; j < 16; ++j) { v[j] = xr[64 * j]; s += (v[j].x * v[j].x + v[j].y * v[j].y) + (v[j].z * v[j].z + v[j].w * v[j].w); }
        const float rstd = rsqrtf(wave_sum(s) * (1.f / DM) + EPS);
#pragma unroll
        for (int j = 0; j < 16; ++j) xr[64 * j] = v[j] * rstd * gr[64 * j];
    }
}

#ifndef MK_ONE_LAUNCH
#define MK_ONE_LAUNCH 1
#endif
constexpr int N_PHASES = 12;
struct Args { const float* in[25]; float* out; unsigned char* ws; int ph_lo, ph_hi; };
__global__ void __launch_bounds__(NTHR, 2) fwd_kernel(Args args) {
    extern __shared__ __attribute__((aligned(16))) unsigned char lds[];
    Frame F;
    F.lds = (LAS unsigned char*)lds;
    F.wave = __builtin_amdgcn_readfirstlane((int)threadIdx.x >> 6);
    F.G = gridDim.x; { const int bx = blockIdx.x; F.vcu = (F.G % 8 == 0) ? (bx % 8) * (F.G / 8) + bx / 8 : bx; }
#pragma unroll
    for (int i = 0; i < 25; ++i) F.in[i] = args.in[i];
    F.out = args.out; F.ws = args.ws;
    volatile LAS unsigned* MISC = (volatile LAS unsigned*)(F.lds + MISC_OFF);
    for (int u = threadIdx.x; u < (LDS_BYTES - LDSCTL_OFF) / 4; u += NTHR) ((LAS unsigned*)(F.lds + LDSCTL_OFF))[u] = 0u;
    __syncthreads();
    const int lo = args.ph_lo, hi = args.ph_hi;
    XcdBarrier bar; bar.bar = (unsigned*)(F.ws + WS_CTL) + CW_BAR; bar.x = 0; bar.st = nullptr;
    if (hi - lo > 1) bar = xcd_barrier_post((unsigned*)(F.ws + WS_CTL) + CW_BAR, MISC + 8);
#ifndef PH_MASK
#define PH_MASK 0xfff
#endif
#define IN(k) (((PH_MASK >> (k)) & 1) && lo <= (k) && (k) < hi)
#define SEAM(k) do { if (lo <= (k) && (k) + 1 < hi) xcd_barrier(bar); } while (0)

    if (IN(0)) { ph0_prologue(F); } SEAM(0);

    if (IN(1)) {
        const bf16* xn = (const bf16*)((unsigned char*)F.out + OY_XN); const bf16* Wint = (const bf16*)(F.ws + WS_RA);
        ph1_alr(F, xn, Wint + (size_t)WA_ROW * DM);
        pg8::MultiOrder S; S.init(DM, F.G, (int)blockIdx.x);
        S.add(xn, Wint, T, NMAIN); S.add(Wint + (size_t)WV_ROW * DM, xn, GV, T); S.add(F.ws + WS_MEMN, F.ws + WS_WKV, 512, 2048); S.add(F.ws + WS_WKV + (size_t)1024 * DM * 2, F.ws + WS_MEMN, 1024, 512);
        pg8::EpiZ E{(bf16*)(F.ws + WS_ZS), (bf16*)(F.ws + WS_GATES), F.in[I_BMERGE], (bf16*)(F.ws + WS_VT), F.out + O_MKP, F.out + O_MVP, (bf16*)(F.ws + WS_MKV), (bf16*)(F.ws + WS_MVT)};
        pg8::gemm_phase<pg8::EpiZ, pg8::MultiOrder, true, true>(F.lds, DM, S, E);
    } SEAM(1);

    if (IN(2)) { ph_g0(F); ph_conv(F); } SEAM(2);
    if (IN(3)) { ph_g1(F); ph_xattn(F); } SEAM(3);
    if (IN(4)) { ph_g2(F); } SEAM(4);
    if (IN(5)) { ph_g3(F); } SEAM(5);

    if (IN(6)) {
        pg8::StaticOrder S; S.init1((unsigned char*)F.out + OY_BR, F.ws + WS_WBR, T, DM, DM, F.G, (int)blockIdx.x);
        pg8::EpiMix E{(const bf16*)(F.ws + WS_GATES), (bf16*)(F.ws + WS_MIX)};
        pg8::gemm_phase<pg8::EpiMix, pg8::StaticOrder, true, true>(F.lds, DM, S, E);
    } SEAM(6);

    if (IN(7)) {
        pg8::StaticOrder S; S.init1(F.ws + WS_MIX, F.ws + WS_WOUT, T, DM, DM, F.G, (int)blockIdx.x);
        pg8::EpiX1 E{F.in[I_XP], F.in[I_XS], F.out};
        pg8::gemm_phase<pg8::EpiX1, pg8::StaticOrder, true, true>(F.lds, DM, S, E);
    } SEAM(7);

    if (IN(8)) { ph8_hn_ffnw(F); } SEAM(8);

    if (IN(9)) {
        pg8::StaticOrder S; S.init1(F.ws + WS_HN, F.ws + WS_RA, T, NGU_T, DM, F.G, (int)blockIdx.x);
        pg8::EpiGU E{(bf16*)(F.ws + WS_GATES)};
        pg8::gemm_phase<pg8::EpiGU, pg8::StaticOrder, true, true>(F.lds, DM, S, E);
    } SEAM(9);

    if (IN(10)) {
        pg8::StaticOrder S; S.init1(F.ws + WS_GATES, F.ws + WS_WDN, T, DM, DFF, F.G, (int)blockIdx.x);
        pg8::EpiDown E{F.out};
        pg8::gemm_phase<pg8::EpiDown, pg8::StaticOrder, true, true>(F.lds, DFF, S, E);
    } SEAM(10);

    if (IN(11)) { ph11_final(F); }
#undef IN
#undef SEAM
}

extern "C" void kernel_launch(void* const* d_in, const int* in_sizes, int n_in, void* d_out, int out_size, void* d_ws, size_t ws_size, hipStream_t stream) {
    static int grid = 0;
    if (grid == 0) {
        if (n_in != 25 || in_sizes[0] != TP * DM || out_size != 94441472 || ws_size < WS_END) { fprintf(stderr, "kernel_launch: unexpected problem shape (n_in %d, out %d, ws %zu); nothing launched\n", n_in, out_size, ws_size); grid = -1; return; }
        int dev = 0, cus = 0, per_cu = 0;
        if (hipGetDevice(&dev) != hipSuccess || hipDeviceGetAttribute(&cus, hipDeviceAttributeMultiprocessorCount, dev) != hipSuccess) { grid = -1; return; }
        if (hipFuncSetAttribute((const void*)fwd_kernel, hipFuncAttributeMaxDynamicSharedMemorySize, LDS_BYTES) != hipSuccess) { fprintf(stderr, "kernel_launch: hipFuncSetAttribute failed\n"); grid = -1; return; }
        if (hipOccupancyMaxActiveBlocksPerMultiprocessor(&per_cu, (const void*)fwd_kernel, NTHR, LDS_BYTES) != hipSuccess || per_cu < 1) { fprintf(stderr, "kernel_launch: occupancy query says %d blocks per CU\n", per_cu); }
        (void)hipGetLastError();
        grid = cus;
    }
    if (grid < 0) return;
    if (hipMemsetAsync((char*)d_ws + WS_CTL, 0, CTL_ZERO_BYTES, stream) != hipSuccess) return;
    Args a{};
    for (int i = 0; i < 25; ++i) a.in[i] = (const float*)d_in[i];
    a.out = (float*)d_out; a.ws = (unsigned char*)d_ws;
#if MK_ONE_LAUNCH
    a.ph_lo = 0; a.ph_hi = N_PHASES;
    hipLaunchKernelGGL(fwd_kernel, dim3(grid), dim3(NTHR), LDS_BYTES, stream, a);
#else
    for (int p = 0; p < N_PHASES; ++p) { a.ph_lo = p; a.ph_hi = p + 1; hipLaunchKernelGGL(fwd_kernel, dim3(grid), dim3(NTHR), LDS_BYTES, stream, a); }
#endif
}
```
